# Optimizing an MI355X kernel written in HIP

```python
import math
import jax, jax.numpy as jnp
from jax import lax
import numpy as np

D_MODEL = 1024
BATCH = 8
SEQ = 8192
DEPTH = 1

CTX_LEN = 256
GRID_W = 64
W_R = 1280
H_R = 5
BW = W_R // H_R
LRU_C = 8.0
CONV_R = 4
CONV_R_LEFT = 2
W_G = 1024
H_G = 8
GC = W_G // H_G
CHUNK = 128
D_FF = 2816
N_MOD = 6
EPS = 1e-6
OFF_RX = 0
OFF_RG = OFF_RX + W_R
OFF_U = OFF_RG + W_R
OFF_V = OFF_U + W_G
OFF_GR = OFF_V + W_G
OFF_GG = OFF_GR + D_MODEL
N_IN = OFF_GG + D_MODEL

kernel_name = "hybrid_rglru_gmlp_convffn_diffusion_block"


def _rmsnorm(x, g):
    xf = x.astype(jnp.float32)
    y = xf * lax.rsqrt(jnp.mean(xf * xf, axis=-1, keepdims=True) + EPS)
    return (y * g.astype(jnp.float32)).astype(x.dtype)


def _modulate(x, g, shift, scale):
    return _rmsnorm(x, g) * (1.0 + scale) + shift


def _dwconv1d(x, w, b):
    C = x.shape[-1]
    y = lax.conv_general_dilated(x, w[:, None, :], window_strides=(1,),
                                 padding=[(CONV_R_LEFT, CONV_R - 1 - CONV_R_LEFT)],
                                 dimension_numbers=('NWC', 'WIO', 'NWC'),
                                 feature_group_count=C)
    return y + b


def _dwconv2d(x, w, b):
    C = x.shape[-1]
    y = lax.conv_general_dilated(x, w[:, :, None, :], window_strides=(1, 1),
                                 padding=[(1, 1), (1, 1)],
                                 dimension_numbers=('NHWC', 'HWIO', 'NHWC'),
                                 feature_group_count=C)
    return y + b


def _linear_scan(a, b, h0, reverse):
    def step(h, ab):
        a_t, b_t = ab
        h = a_t * h + b_t
        return h, h
    h_last, hs = lax.scan(step, h0, (jnp.swapaxes(a, 0, 1), jnp.swapaxes(b, 0, 1)), reverse=reverse)
    return jnp.swapaxes(hs, 0, 1), h_last


def _rglru_dir(xr, lam, wa, ba, wx, bx, h0, reverse):
    B, T, _ = xr.shape
    xh = xr.reshape(B, T, H_R, BW)
    r = jax.nn.sigmoid(jnp.einsum('bthi,hij->bthj', xh, wa).reshape(B, T, W_R) + ba)
    i = jax.nn.sigmoid(jnp.einsum('bthi,hij->bthj', xh, wx).reshape(B, T, W_R) + bx)
    log_a = (-LRU_C * r * jax.nn.softplus(-lam)).astype(jnp.float32)
    a = jnp.exp(log_a)
    mult = jnp.sqrt(-jnp.expm1(2.0 * log_a))
    bt = mult * (i * xr).astype(jnp.float32)
    hs, h_last = _linear_scan(a, bt, h0, reverse)
    return hs.astype(xr.dtype), h_last


def _rglru_bidir(xr, lam, wa, ba, wx, bx, h0_f, h0_b):
    y_f, h_f = _rglru_dir(xr, lam[0], wa[0], ba[0], wx[0], bx[0], h0_f, False)
    y_b, h_b = _rglru_dir(xr, lam[1], wa[1], ba[1], wx[1], bx[1], h0_b, True)
    return y_f + y_b, h_f, h_b


def _chunk_mlp(u_raw, v_raw, g_v, w_s, b_s):
    B, T, _ = u_raw.shape
    u = jax.nn.gelu(u_raw)
    v = _rmsnorm(jax.nn.gelu(v_raw), g_v).reshape(B, T // CHUNK, CHUNK, H_G, GC)
    s = jnp.einsum('hpq,bnqhc->bnphc', w_s, v) + b_s[None, None, :, :, None]
    return u * s.reshape(B, T, W_G)


def _mixer_out(p, y_lru, g_v, w_s, b_s, w_pr, w_pg, w_out):
    y_r = jax.nn.gelu(p[..., OFF_RG:OFF_RG + W_R]) * y_lru
    y_g = _chunk_mlp(p[..., OFF_U:OFF_U + W_G], p[..., OFF_V:OFF_V + W_G], g_v, w_s, b_s)
    gate_r = jax.nn.sigmoid(p[..., OFF_GR:OFF_GR + D_MODEL])
    gate_g = jax.nn.sigmoid(p[..., OFF_GG:OFF_GG + D_MODEL])
    merged = gate_r * (y_r @ w_pr) + gate_g * (y_g @ w_pg)
    return merged @ w_out


def _conv_ffn(h, w_up, cw, cb, w_down, grid_h, grid_w):
    B, T, _ = h.shape
    up = h @ w_up
    g = _dwconv2d(up[..., :D_FF].reshape(B, grid_h, grid_w, D_FF), cw, cb).reshape(B, T, D_FF)
    return (jax.nn.gelu(g) * up[..., D_FF:]) @ w_down


def setup_inputs(seed: int = 0) -> dict:
    key = jax.random.key(seed)
    ks = jax.random.split(key, 32)
    f32 = jnp.float32

    def nrm(k, shape, fan_in, gain=1.0):
        return (gain * fan_in ** -0.5) * jax.random.normal(k, shape, f32)

    u = jax.random.uniform(ks[8], (DEPTH, 2, W_R), f32, minval=0.9, maxval=0.999)
    a1 = u ** (1.0 / LRU_C)
    lru_lam = jnp.log(a1) - jnp.log1p(-a1)
    return {
        "x": jax.random.normal(ks[0], (BATCH, SEQ, D_MODEL), f32),
        "c": jax.random.normal(ks[1], (BATCH, D_MODEL), f32),
        "ctx": jax.random.normal(ks[2], (BATCH, CTX_LEN, D_MODEL), f32),
        "c_ctx": jax.random.normal(ks[3], (D_MODEL,), f32),
        "w_mod": nrm(ks[4], (DEPTH, D_MODEL, N_MOD * D_MODEL), D_MODEL, 0.5),
        "b_mod": 0.02 * jax.random.normal(ks[5], (DEPTH, N_MOD * D_MODEL), f32),
        "g_norm1": 1.0 + 0.02 * jax.random.normal(ks[6], (DEPTH, D_MODEL), f32),
        "w_in": nrm(ks[7], (DEPTH, D_MODEL, N_IN), D_MODEL),
        "conv_w": nrm(ks[9], (DEPTH, CONV_R, W_R), CONV_R),
        "conv_b": 0.02 * jax.random.normal(ks[10], (DEPTH, W_R), f32),
        "lru_lam": lru_lam,
        "lru_wa": nrm(ks[11], (DEPTH, 2, H_R, BW, BW), BW),
        "lru_ba": 0.02 * jax.random.normal(ks[12], (DEPTH, 2, W_R), f32),
        "lru_wx": nrm(ks[13], (DEPTH, 2, H_R, BW, BW), BW),
        "lru_bx": 0.02 * jax.random.normal(ks[14], (DEPTH, 2, W_R), f32),
        "g_v": 1.0 + 0.02 * jax.random.normal(ks[15], (DEPTH, W_G), f32),
        "w_s": nrm(ks[16], (DEPTH, H_G, CHUNK, CHUNK), CHUNK),
        "b_s": 1.0 + 0.02 * jax.random.normal(ks[17], (DEPTH, CHUNK, H_G), f32),
        "w_pr": nrm(ks[18], (DEPTH, W_R, D_MODEL), W_R),
        "w_pg": nrm(ks[19], (DEPTH, W_G, D_MODEL), W_G),
        "w_out": nrm(ks[20], (DEPTH, D_MODEL, D_MODEL), D_MODEL),
        "g_norm2": 1.0 + 0.02 * jax.random.normal(ks[21], (DEPTH, D_MODEL), f32),
        "w_up": nrm(ks[22], (DEPTH, D_MODEL, 2 * D_FF), D_MODEL),
        "ffn_conv_w": nrm(ks[23], (DEPTH, 3, 3, D_FF), 9.0),
        "ffn_conv_b": 0.02 * jax.random.normal(ks[24], (DEPTH, D_FF), f32),
        "w_down": nrm(ks[25], (DEPTH, D_FF, D_MODEL), D_FF),
        "g_final": 1.0 + 0.02 * jax.random.normal(ks[26], (D_MODEL,), f32),
    }


def reference(x, c, ctx, c_ctx, w_mod, b_mod, g_norm1, w_in, conv_w, conv_b, lru_lam,
              lru_wa, lru_ba, lru_wx, lru_bx, g_v, w_s, b_s, w_pr, w_pg, w_out,
              g_norm2, w_up, ffn_conv_w, ffn_conv_b, w_down, g_final):
    B, T, _ = x.shape
    rows = T // GRID_W
    t_ctx = ctx.shape[1]
    for l in range(DEPTH):
        last = l == DEPTH - 1
        m_x = (jax.nn.silu(c) @ w_mod[l] + b_mod[l]).reshape(B, N_MOD, 1, D_MODEL)
        m_c = (jax.nn.silu(c_ctx) @ w_mod[l] + b_mod[l]).reshape(N_MOD, D_MODEL)
        lru = (lru_lam[l], lru_wa[l], lru_ba[l], lru_wx[l], lru_bx[l])
        gmlp_and_merge = (g_v[l], w_s[l], b_s[l], w_pr[l], w_pg[l], w_out[l])

        hc = _modulate(ctx, g_norm1[l], m_c[0], m_c[1])
        pc = hc @ w_in[l][:, :(W_R if last else N_IN)]
        xr_c = _dwconv1d(pc[..., OFF_RX:OFF_RX + W_R], conv_w[l], conv_b[l])
        h0 = jnp.zeros((B, W_R), jnp.float32)
        yc_lru, hc_f, hc_b = _rglru_bidir(xr_c, *lru, h0, h0)

        hx = _modulate(x, g_norm1[l], m_x[:, 0], m_x[:, 1])
        px = hx @ w_in[l]
        xr_x = _dwconv1d(px[..., OFF_RX:OFF_RX + W_R], conv_w[l], conv_b[l])
        yx_lru, _, _ = _rglru_bidir(xr_x, *lru, hc_f, hc_b)
        x = x + m_x[:, 2] * _mixer_out(px, yx_lru, *gmlp_and_merge)
        if not last:
            ctx_mid = ctx + m_c[2] * _mixer_out(pc, yc_lru, *gmlp_and_merge)

        h2 = _modulate(x, g_norm2[l], m_x[:, 3], m_x[:, 4])
        x = x + m_x[:, 5] * _conv_ffn(h2, w_up[l], ffn_conv_w[l], ffn_conv_b[l], w_down[l], rows, GRID_W)
        if not last:
            h2c = _modulate(ctx_mid, g_norm2[l], m_c[3], m_c[4])
            ctx = ctx_mid + m_c[5] * _conv_ffn(h2c, w_up[l], ffn_conv_w[l], ffn_conv_b[l], w_down[l], 1, t_ctx)
    return _rmsnorm(x, g_final)
```

```cpp
#include <hip/hip_runtime.h>
#include <hip/hip_cooperative_groups.h>
#include <cstdio>
namespace cg = cooperative_groups;

#ifndef ONE_LAUNCH
#define ONE_LAUNCH 1
#endif

#define LAS __attribute__((address_space(3)))
typedef unsigned short bf16_t;
typedef short bf16x8 __attribute__((ext_vector_type(8)));
typedef float f32x4 __attribute__((ext_vector_type(4)));
typedef unsigned u32x4 __attribute__((ext_vector_type(4)));
typedef unsigned u32x2 __attribute__((ext_vector_type(2)));

constexpr int DM = 1024, NB = 8, SEQ = 8192, CTXL = 256, WR = 1280, NIN = 6656, DFF = 2816;
constexpr int MROWS = NB * SEQ;
constexpr int MCTX = NB * CTXL;
constexpr int NCH = 132;
constexpr int NPH = 14;
constexpr int LDS_BYTES = 131072;

constexpr size_t al256(size_t x) { return (x + 255) & ~(size_t)255; }
constexpr size_t WS_WIN = 0;
constexpr size_t WS_WG = WS_WIN + al256((size_t)NIN * DM * 2);
constexpr size_t WS_WPRG = WS_WG + al256((size_t)20 * 256 * 256 * 2);
constexpr size_t WS_WOUT = WS_WPRG + al256((size_t)1024 * 2304 * 2);
constexpr size_t WS_WUP = WS_WOUT + al256((size_t)1024 * 1024 * 2);
constexpr size_t WS_WDN = WS_WUP + al256((size_t)5632 * 1024 * 2);
constexpr size_t WS_WS = WS_WDN + al256((size_t)1024 * 2816 * 2);
constexpr size_t WS_MPART = WS_WS + al256((size_t)8 * 128 * 128 * 2);
constexpr size_t WS_MFIN = WS_MPART + al256((size_t)16 * 9 * 6144 * 4);
constexpr size_t WS_VSS = WS_MFIN + al256((size_t)9 * 6144 * 4);
constexpr size_t WS_AGG = WS_VSS + al256((size_t)MROWS * 16 * 4);
constexpr size_t WS_CARRY = WS_AGG + al256((size_t)NB * 2 * NCH * WR * 8);
constexpr size_t WS_PC = WS_CARRY + al256((size_t)NB * 2 * 128 * WR * 4);
constexpr size_t WS_SPT = WS_PC + al256((size_t)MCTX * WR * 2);
constexpr size_t WS_PX = WS_SPT + al256((size_t)2 * WR * 4);
constexpr size_t WS_END = WS_PX + (size_t)MROWS * NIN * 2;
constexpr size_t WS_H2 = WS_PX;
constexpr size_t WS_UG = WS_H2 + (size_t)MROWS * DM * 2;
constexpr size_t WS_UV = WS_UG + (size_t)MROWS * DFF * 2;
static_assert(WS_UV + (size_t)MROWS * DFF * 2 <= WS_END, "ffn buffers fit in px region");
static_assert(WS_END <= (size_t)1073741824, "workspace fits");

constexpr int OFF_RG = 1280, OFF_U = 2560, OFF_V = 3584, OFF_GR = 4608, OFF_GG = 5632;

struct Params {
    const float* in[27];
    float* out;
    unsigned char* ws;
    int ph_lo, ph_hi;
};

__device__ __forceinline__ Params load_params() {
    const __attribute__((address_space(4))) unsigned long long* k = (const __attribute__((address_space(4))) unsigned long long*)__builtin_amdgcn_kernarg_segment_ptr();
    asm volatile("" : "+s"(k));
    Params q;
#pragma unroll
    for (int i = 0; i < 27; ++i) q.in[i] = (const float*)k[i];
    q.out = (float*)k[27]; q.ws = (unsigned char*)k[28]; q.ph_lo = 0; q.ph_hi = 0;
    return q;
}

__device__ __forceinline__ unsigned pk_bf16(float lo, float hi) { unsigned r; asm("v_cvt_pk_bf16_f32 %0, %1, %2" : "=v"(r) : "v"(lo), "v"(hi)); return r; }
__device__ __forceinline__ float bf_lo(unsigned w) { return __uint_as_float(w << 16); }
__device__ __forceinline__ float bf_hi(unsigned w) { return __uint_as_float(w & 0xffff0000u); }
__device__ __forceinline__ float sigmoidf_(float x) { return __builtin_amdgcn_rcpf(1.0f + __expf(-x)); }
__device__ __forceinline__ float gelu_t(float x) { return x * sigmoidf_(1.5957691216057308f * (x + 0.044715f * x * x * x)); }
struct Em1K { float c3, c4, c5, c6; };
__device__ __forceinline__ Em1K em1k_make() { Em1K k{0.16666667f, 0.041666668f, 0.008333334f, 0.0013888889f}; asm volatile("" : "+v"(k.c3), "+v"(k.c4), "+v"(k.c5), "+v"(k.c6)); return k; }
__device__ __forceinline__ float em1fk(float x, const Em1K& k) {
    const float p = x * (1.0f + x * (0.5f + x * (k.c3 + x * (k.c4 + x * (k.c5 + x * k.c6)))));
    return (__builtin_fabsf(x) < 0.25f) ? p : (__expf(x) - 1.0f);
}
__device__ __forceinline__ float em1f(float x) {
    const float p = x * (1.0f + x * (0.5f + x * (0.16666667f + x * (0.041666668f + x * (0.008333334f + x * 0.0013888889f)))));
    return (__builtin_fabsf(x) < 0.25f) ? p : (__expf(x) - 1.0f);
}
#define DPPF(old, src, ctrl) __int_as_float(__builtin_amdgcn_update_dpp(__float_as_int(old), __float_as_int(src), (ctrl), 0xf, 0xf, false))

__device__ __forceinline__ void row_scan_fwd(float& a, float& b) {
    float ap, bp;
    ap = DPPF(1.0f, a, 0x111); bp = DPPF(0.0f, b, 0x111); b = a * bp + b; a = a * ap;
    ap = DPPF(1.0f, a, 0x112); bp = DPPF(0.0f, b, 0x112); b = a * bp + b; a = a * ap;
    ap = DPPF(1.0f, a, 0x114); bp = DPPF(0.0f, b, 0x114); b = a * bp + b; a = a * ap;
    ap = DPPF(1.0f, a, 0x118); bp = DPPF(0.0f, b, 0x118); b = a * bp + b; a = a * ap;
}
__device__ __forceinline__ void row_scan_bwd(float& a, float& b) {
    float ap, bp;
    ap = DPPF(1.0f, a, 0x101); bp = DPPF(0.0f, b, 0x101); b = a * bp + b; a = a * ap;
    ap = DPPF(1.0f, a, 0x102); bp = DPPF(0.0f, b, 0x102); b = a * bp + b; a = a * ap;
    ap = DPPF(1.0f, a, 0x104); bp = DPPF(0.0f, b, 0x104); b = a * bp + b; a = a * ap;
    ap = DPPF(1.0f, a, 0x108); bp = DPPF(0.0f, b, 0x108); b = a * bp + b; a = a * ap;
}

namespace pg8 {
constexpr int BM = 256, BK = 64, HALF = 128, HTB = HALF * BK * 2, NXCD = 8, WGM = 8;
__device__ __forceinline__ int lds_byte(int r, int c) { const int st = (r >> 4) * 2 + (c >> 5), rr = r & 15, cc = c & 31, ob = rr * 64 + cc * 2; return st * 1024 + (ob ^ (((ob >> 9) & 1) << 5)); }
__device__ __forceinline__ void stage_rc(int b, int& R, int& C) { const int st = b / 1024, sb = b % 1024, swz = sb ^ (((sb >> 9) & 1) << 5); R = (st >> 1) * 16 + swz / 64; C = (st & 1) * 32 + (swz % 64) / 2; }
__device__ __forceinline__ int perm32(int rho) { const int n = rho >> 4, i = rho & 15; return 8 * (i >> 2) + 4 * n + (i & 3); }

struct Unit { int pm, pn, ka0, kb0, nkt, tag; };
struct GemmD { const bf16_t* A; const bf16_t* Bt; int lda, ldb; };

__device__ __forceinline__ void tile_map(int L, int nM, int nN, int nwg, int& pm, int& pn) {
    int wgid = L; { const int q = nwg / NXCD, r = nwg % NXCD, xcd = wgid % NXCD, off = wgid / NXCD; wgid = (xcd < r ? xcd * (q + 1) : r * (q + 1) + (xcd - r) * q) + off; }
    const int nig = WGM * nN, gid = wgid / nig, fm = gid * WGM, gsz = (nM - fm) < WGM ? (nM - fm) : WGM;
    pm = fm + ((wgid % nig) % gsz); pn = (wgid % nig) / gsz;
}

template <class Epi, class Sched>
__device__ __forceinline__ void gemm_phase(LAS unsigned char* lds, const GemmD g, const Sched& S, const Epi& E) {
    const int tid = threadIdx.x, wid = __builtin_amdgcn_readfirstlane(tid >> 6), lane = tid & 63, wr = wid >> 2, wc = wid & 3, fr = lane & 15, fq = lane >> 4;
    unsigned voffA[2], voffB[2];
#pragma unroll
    for (int i = 0; i < 2; ++i) { int R, C; stage_rc(tid * 16 + i * 8192, R, C); const int Rb = Epi::PERM ? ((R & ~31) + perm32(R & 31)) : R;
        voffA[i] = (unsigned)(R * g.lda + C) * 2u; voffB[i] = (unsigned)(Rb * g.ldb + C) * 2u; }
    const size_t kstep = (size_t)(BK * 2);
    const size_t hstepA = (size_t)HALF * g.lda * 2, hstepB = (size_t)HALF * g.ldb * 2;
    const unsigned ldsw = (unsigned)wid * 1024u;
    const int aoff = lds_byte(wr * 64 + fr, fq * 8), boff = lds_byte(wc * 32 + fr, fq * 8);
#define PG8_SA(b, h) (((b) * 2 + (h)) * HTB)
#define PG8_SB(b, h) ((4 + (b) * 2 + (h)) * HTB)
#define PG8_STAGE(bufoff, gbase, voff) do { _Pragma("unroll") for (int _i = 0; _i < 2; ++_i) \
        __builtin_amdgcn_global_load_lds((const unsigned*)((const char*)(gbase) + (voff)[_i]), (LAS unsigned*)(lds + (bufoff) + ldsw + _i * 8192), 16, 0, 0); } while (0)
#define PG8_LDA(dst, b, h) do { _Pragma("unroll") for (int m = 0; m < 4; ++m) _Pragma("unroll") for (int k = 0; k < 2; ++k) dst[m][k] = *(const LAS bf16x8*)(lds + PG8_SA(b, h) + aoff + m * 2048 + k * 1024); } while (0)
#define PG8_LDB(dst, b, h) do { _Pragma("unroll") for (int n = 0; n < 2; ++n) _Pragma("unroll") for (int k = 0; k < 2; ++k) dst[n][k] = *(const LAS bf16x8*)(lds + PG8_SB(b, h) + boff + n * 2048 + k * 1024); } while (0)
#define PG8_MMA(ai, bj, At, Bt) do { __builtin_amdgcn_s_setprio(1); _Pragma("unroll") for (int m = 0; m < 4; ++m) _Pragma("unroll") for (int n = 0; n < 2; ++n) _Pragma("unroll") for (int k = 0; k < 2; ++k) \
        acc[ai][bj][m][n] = __builtin_amdgcn_mfma_f32_16x16x32_bf16(Bt[n][k], At[m][k], acc[ai][bj][m][n], 0, 0, 0); __builtin_amdgcn_s_setprio(0); } while (0)
#define PG8_WAIT_V(n) asm volatile("s_waitcnt vmcnt(" #n ")" ::: "memory")
#define PG8_WAIT_L(n) asm volatile("s_waitcnt lgkmcnt(" #n ")" ::: "memory")
#define PG8_BAR __builtin_amdgcn_s_barrier()
#define PG8_SCHED __builtin_amdgcn_sched_barrier(0)
    Unit cur, nxt; int ui = 0;
    if (!S.next(0, cur)) return;
    f32x4 acc[2][2][4][2];
#pragma unroll
    for (int a = 0; a < 2; ++a)
#pragma unroll
        for (int b = 0; b < 2; ++b)
#pragma unroll
            for (int m = 0; m < 4; ++m)
#pragma unroll
                for (int n = 0; n < 2; ++n) acc[a][b][m][n] = (f32x4){0.f, 0.f, 0.f, 0.f};
    bf16x8 At[4][2], B0[2][2], B1[2][2];
    const char* cA = (const char*)g.A + (size_t)cur.pm * 2 * hstepA + (size_t)cur.ka0 * kstep;
    const char* cB = (const char*)g.Bt + (size_t)cur.pn * 2 * hstepB + (size_t)cur.kb0 * kstep;
    PG8_STAGE(PG8_SB(0, 0), cB, voffB); PG8_STAGE(PG8_SA(0, 0), cA, voffA); PG8_STAGE(PG8_SB(0, 1), cB + hstepB, voffB); PG8_STAGE(PG8_SA(0, 1), cA + hstepA, voffA);
    if (wr == 1) PG8_BAR;
    PG8_WAIT_V(4); PG8_BAR;
    PG8_STAGE(PG8_SB(1, 0), cB + kstep, voffB); PG8_STAGE(PG8_SA(1, 0), cA + kstep, voffA); PG8_STAGE(PG8_SB(1, 1), cB + hstepB + kstep, voffB);
    PG8_WAIT_V(6); PG8_BAR;
    for (;;) {
        const bool has_next = S.next(ui + 1, nxt);
        const char* nA = has_next ? (const char*)g.A + (size_t)nxt.pm * 2 * hstepA + (size_t)nxt.ka0 * kstep : cA;
        const char* nB = has_next ? (const char*)g.Bt + (size_t)nxt.pn * 2 * hstepB + (size_t)nxt.kb0 * kstep : cB;
        const int nt = cur.nkt;
#pragma unroll 1
        for (int t = 0; t < nt; t += 2) {
            const bool last = (t == nt - 2);
            const char* a1 = cA + (size_t)(t + 1) * kstep;
            const char* a2 = last ? nA : cA + (size_t)(t + 2) * kstep; const char* b2 = last ? nB : cB + (size_t)(t + 2) * kstep;
            const char* a3 = a2 + kstep; const char* b3 = b2 + kstep;
            PG8_LDB(B0, 0, 0); PG8_SCHED; PG8_LDA(At, 0, 0); PG8_STAGE(PG8_SA(1, 1), a1 + hstepA, voffA);
            PG8_WAIT_L(8); PG8_BAR; PG8_WAIT_L(0); PG8_MMA(0, 0, At, B0); PG8_BAR; PG8_SCHED;
            PG8_LDB(B1, 0, 1); PG8_STAGE(PG8_SB(0, 0), b2, voffB);
            PG8_BAR; PG8_WAIT_L(0); PG8_MMA(0, 1, At, B1); PG8_BAR;
            PG8_LDA(At, 0, 1); PG8_STAGE(PG8_SA(0, 0), a2, voffA);
            PG8_BAR; PG8_WAIT_L(0); PG8_MMA(1, 0, At, B0); PG8_BAR; PG8_SCHED;
            PG8_STAGE(PG8_SB(0, 1), b2 + hstepB, voffB);
            PG8_WAIT_V(6); PG8_BAR; PG8_MMA(1, 1, At, B1); PG8_BAR;
            PG8_LDB(B0, 1, 0); PG8_SCHED; PG8_LDA(At, 1, 0); PG8_STAGE(PG8_SA(0, 1), a2 + hstepA, voffA);
            PG8_WAIT_L(8); PG8_BAR; PG8_WAIT_L(0); PG8_MMA(0, 0, At, B0); PG8_BAR; PG8_SCHED;
            PG8_LDB(B1, 1, 1); PG8_STAGE(PG8_SB(1, 0), b3, voffB);
            PG8_BAR; PG8_WAIT_L(0); PG8_MMA(0, 1, At, B1); PG8_BAR;
            PG8_LDA(At, 1, 1); PG8_STAGE(PG8_SA(1, 0), a3, voffA);
            PG8_BAR; PG8_WAIT_L(0); PG8_MMA(1, 0, At, B0); PG8_BAR; PG8_SCHED;
            PG8_STAGE(PG8_SB(1, 1), b3 + hstepB, voffB);
            PG8_WAIT_V(6); PG8_BAR; PG8_MMA(1, 1, At, B1); PG8_BAR;
        }
        int efr = fr, efq = fq; asm volatile("" : "+v"(efr), "+v"(efq));
        const bool zero = E(acc, cur, wr, wc, efr, efq);
        if (!has_next) break;
        if (zero) {
#pragma unroll
            for (int a = 0; a < 2; ++a)
#pragma unroll
                for (int b = 0; b < 2; ++b)
#pragma unroll
                    for (int m = 0; m < 4; ++m)
#pragma unroll
                        for (int n = 0; n < 2; ++n) acc[a][b][m][n] = (f32x4){0.f, 0.f, 0.f, 0.f};
        }
        cur = nxt; cA = nA; cB = nB; ++ui;
    }
    PG8_WAIT_V(0);
    if (wr == 0) PG8_BAR;
    PG8_BAR;
#undef PG8_SA
#undef PG8_SB
#undef PG8_STAGE
#undef PG8_LDA
#undef PG8_LDB
#undef PG8_MMA
#undef PG8_WAIT_V
#undef PG8_WAIT_L
#undef PG8_BAR
#undef PG8_SCHED
}
}
using pg8::Unit;

struct SchedPlain {
    int nM, nN, nwg, G, c, nkt;
    __device__ __forceinline__ bool next(int i, Unit& u) const {
        const long L = (long)i * G + c; if (L >= nwg) return false;
        pg8::tile_map((int)L, nM, nN, nwg, u.pm, u.pn); u.ka0 = 0; u.kb0 = 0; u.nkt = nkt; u.tag = 0; return true; }
};
struct SchedIn {
    int G, c;
    __device__ __forceinline__ bool next(int i, Unit& u) const {
        const long L = (long)i * G + c; if (L >= 6656 + 40) return false;
        if (L < 6656) pg8::tile_map((int)L, 256, 26, 6656, u.pm, u.pn);
        else { const int e = (int)L - 6656; u.pm = 256 + e / 5; u.pn = e % 5; }
        u.ka0 = 0; u.kb0 = 0; u.nkt = 16; u.tag = 0; return true; }
};
struct SchedMerge {
    int G, c;
    __device__ __forceinline__ bool next(int i, Unit& u) const {
        const long L = (long)(i >> 1) * G + c; if (L >= 1024) return false;
        pg8::tile_map((int)L, 256, 4, 1024, u.pm, u.pn); const int part = i & 1;
        u.ka0 = part ? 20 : 0; u.kb0 = u.ka0; u.nkt = part ? 16 : 20; u.tag = part; return true; }
};
struct SchedGate {
    int nM, nwg, G, c;
    __device__ __forceinline__ bool next(int i, Unit& u) const {
        const long L = (long)i * G + c; if (L >= nwg) return false;
        pg8::tile_map((int)L, nM, 20, nwg, u.pm, u.pn); u.ka0 = (u.pn >> 2) * 4; u.kb0 = 0; u.nkt = 4; u.tag = 0; return true; }
};

struct EpiIn {
    static constexpr bool PERM = true;
    bf16_t* PX; bf16_t* PC; float* VSS;
    __device__ __forceinline__ bool operator()(f32x4 (&acc)[2][2][4][2], const Unit& u, int wr, int wc, int fr, int fq) const {
        const int pn = u.pn;
        const int mode = (u.pm >= 256 || pn < 5) ? 0 : (pn < 14 ? 1 : (pn < 18 ? 2 : 3));
#pragma unroll
        for (int ai = 0; ai < 2; ++ai)
#pragma unroll
            for (int m = 0; m < 4; ++m) {
                const int r = u.pm * 256 + ai * 128 + wr * 64 + m * 16 + fr;
                float ss = 0.f;
#pragma unroll
                for (int bj = 0; bj < 2; ++bj) {
                    const int c0 = pn * 256 + bj * 128 + wc * 32 + fq * 8;
                    float v[8];
#pragma unroll
                    for (int n = 0; n < 2; ++n)
#pragma unroll
                        for (int j = 0; j < 4; ++j) {
                            float x = acc[ai][bj][m][n][j];
                            if (mode == 1 || mode == 2) x = gelu_t(x);
                            else if (mode == 3) x = sigmoidf_(x);
                            v[n * 4 + j] = x; ss += x * x;
                        }
                    u32x4 w; w.x = pk_bf16(v[0], v[1]); w.y = pk_bf16(v[2], v[3]); w.z = pk_bf16(v[4], v[5]); w.w = pk_bf16(v[6], v[7]);
                    if (u.pm < 256) *(u32x4*)(PX + (size_t)r * NIN + c0) = w;
                    else *(u32x4*)(PC + (size_t)(r - MROWS) * WR + c0) = w;
                }
                if (mode == 2) {
                    ss += __shfl_xor(ss, 16); ss += __shfl_xor(ss, 32);
                    if (fq == 0) VSS[(size_t)r * 16 + (pn - 14) * 4 + wc] = ss;
                }
            }
        return true;
    }
};

struct EpiMerge {
    static constexpr bool PERM = true;
    bf16_t* PX;
    __device__ __forceinline__ bool operator()(f32x4 (&acc)[2][2][4][2], const Unit& u, int wr, int wc, int fr, int fq) const {
#pragma unroll
        for (int ai = 0; ai < 2; ++ai)
#pragma unroll
            for (int m = 0; m < 4; ++m) {
                const int r = u.pm * 256 + ai * 128 + wr * 64 + m * 16 + fr;
#pragma unroll
                for (int bj = 0; bj < 2; ++bj) {
                    const int c0 = u.pn * 256 + bj * 128 + wc * 32 + fq * 8;
                    bf16_t* rowp = PX + (size_t)r * NIN;
                    const u32x4 gg = *(const u32x4*)(rowp + OFF_GG + c0);
                    float g[8] = {bf_lo(gg.x), bf_hi(gg.x), bf_lo(gg.y), bf_hi(gg.y), bf_lo(gg.z), bf_hi(gg.z), bf_lo(gg.w), bf_hi(gg.w)};
                    if (u.tag == 0) {
                        const u32x4 gr = *(const u32x4*)(rowp + OFF_GR + c0);
                        const float q[8] = {bf_lo(gr.x), bf_hi(gr.x), bf_lo(gr.y), bf_hi(gr.y), bf_lo(gr.z), bf_hi(gr.z), bf_lo(gr.w), bf_hi(gr.w)};
#pragma unroll
                        for (int n = 0; n < 2; ++n)
#pragma unroll
                            for (int j = 0; j < 4; ++j) acc[ai][bj][m][n][j] *= q[n * 4 + j] * __builtin_amdgcn_rcpf(fmaxf(g[n * 4 + j], 1e-30f));
                    } else {
                        float v[8];
#pragma unroll
                        for (int n = 0; n < 2; ++n)
#pragma unroll
                            for (int j = 0; j < 4; ++j) v[n * 4 + j] = acc[ai][bj][m][n][j] * fmaxf(g[n * 4 + j], 1e-30f);
                        u32x4 w; w.x = pk_bf16(v[0], v[1]); w.y = pk_bf16(v[2], v[3]); w.z = pk_bf16(v[4], v[5]); w.w = pk_bf16(v[6], v[7]);
                        *(u32x4*)(rowp + c0) = w;
                    }
                }
            }
        return u.tag != 0;
    }
};

struct EpiRes {
    static constexpr bool PERM = false;
    const float* res; float* out; const float* gate;
    __device__ __forceinline__ bool operator()(f32x4 (&acc)[2][2][4][2], const Unit& u, int wr, int wc, int fr, int fq) const {
        const int b = u.pm >> 5;
        f32x4 gv[2][2];
#pragma unroll
        for (int bj = 0; bj < 2; ++bj)
#pragma unroll
            for (int n = 0; n < 2; ++n) gv[bj][n] = *(const f32x4*)(gate + (size_t)b * 6144 + u.pn * 256 + bj * 128 + wc * 32 + n * 16 + fq * 4);
#pragma unroll
        for (int ai = 0; ai < 2; ++ai)
#pragma unroll
            for (int m = 0; m < 4; ++m) {
                const int r = u.pm * 256 + ai * 128 + wr * 64 + m * 16 + fr;
#pragma unroll
                for (int bj = 0; bj < 2; ++bj)
#pragma unroll
                    for (int n = 0; n < 2; ++n) {
                        const size_t o = (size_t)r * DM + u.pn * 256 + bj * 128 + wc * 32 + n * 16 + fq * 4;
                        const f32x4 x = *(const f32x4*)(res + o);
                        *(f32x4*)(out + o) = x + gv[bj][n] * acc[ai][bj][m][n];
                    }
            }
        return true;
    }
};

struct EpiUp {
    static constexpr bool PERM = true;
    bf16_t* UG; bf16_t* UV;
    __device__ __forceinline__ bool operator()(f32x4 (&acc)[2][2][4][2], const Unit& u, int wr, int wc, int fr, int fq) const {
        bf16_t* base = u.pn < 11 ? UG : UV; const int pn = u.pn < 11 ? u.pn : u.pn - 11;
#pragma unroll
        for (int ai = 0; ai < 2; ++ai)
#pragma unroll
            for (int m = 0; m < 4; ++m) {
                const int r = u.pm * 256 + ai * 128 + wr * 64 + m * 16 + fr;
#pragma unroll
                for (int bj = 0; bj < 2; ++bj) {
                    const int c0 = pn * 256 + bj * 128 + wc * 32 + fq * 8;
                    u32x4 w; w.x = pk_bf16(acc[ai][bj][m][0][0], acc[ai][bj][m][0][1]); w.y = pk_bf16(acc[ai][bj][m][0][2], acc[ai][bj][m][0][3]);
                    w.z = pk_bf16(acc[ai][bj][m][1][0], acc[ai][bj][m][1][1]); w.w = pk_bf16(acc[ai][bj][m][1][2], acc[ai][bj][m][1][3]);
                    *(u32x4*)(base + (size_t)r * DFF + c0) = w;
                }
            }
        return true;
    }
};

template <int PASS> struct EpiGate {
    static constexpr bool PERM = false;
    const bf16_t* XR; const float* ba; const float* bx; const float* lam;
    float2* AGG; const float* CARRY; bf16_t* PX;
    __device__ __forceinline__ bool operator()(f32x4 (&acc)[2][2][4][2], const Unit& u, int wr, int wc, int fr, int fq) const {
        const int lane = fq * 16 + fr;
        const Em1K ek = em1k_make();
        const int ch = u.pn * 64 + wc * 16 + fq * 4;
        const bool isctx = u.pm >= 256;
        const int b = isctx ? (u.pm - 256) : (u.pm >> 5);
#pragma unroll
        for (int ai = 0; ai < 2; ++ai) {
            const int row0 = u.pm * 256 + ai * 128 + wr * 64;
            const int cidx = isctx ? (ai * 2 + wr) : (4 + (u.pm & 31) * 4 + ai * 2 + wr);
            u32x2 xrv[4];
#pragma unroll
            for (int m = 0; m < 4; ++m) xrv[m] = *(const u32x2*)(XR + (size_t)(row0 + m * 16 + fr) * WR + ch);
#pragma unroll
            for (int bj = 0; bj < 2; ++bj) {
                const f32x4 bav = *(const f32x4*)(ba + bj * WR + ch), bxv = *(const f32x4*)(bx + bj * WR + ch), sp = *(const f32x4*)(lam + bj * WR + ch);
#pragma unroll
                for (int m = 0; m < 4; ++m)
#pragma unroll
                    for (int j = 0; j < 4; ++j) {
                        const float rg = sigmoidf_(acc[ai][bj][m][0][j] + bav[j]);
                        const float ig = sigmoidf_(acc[ai][bj][m][1][j] + bxv[j]);
                        const float la = sp[j] * rg;
                        const float em = em1fk(la, ek);
                        const float a = 1.0f + em;
                        const float mult = sqrtf(fmaxf(-em * (2.0f + em), 0.0f));
                        const float xv = (j == 0) ? bf_lo(xrv[m].x) : (j == 1) ? bf_hi(xrv[m].x) : (j == 2) ? bf_lo(xrv[m].y) : bf_hi(xrv[m].y);
                        float aa = a, bb = mult * (ig * xv);
                        if (bj == 0) row_scan_fwd(aa, bb); else row_scan_bwd(aa, bb);
                        acc[ai][bj][m][0][j] = aa; acc[ai][bj][m][1][j] = bb;
                        if (j & 1) __builtin_amdgcn_sched_barrier(0);
                    }
                if (PASS == 1) {
                    float TA[4] = {1.f, 1.f, 1.f, 1.f}, TB[4] = {0.f, 0.f, 0.f, 0.f};
#pragma unroll
                    for (int mm = 0; mm < 4; ++mm) { const int m = (bj == 0) ? mm : 3 - mm;
#pragma unroll
                        for (int j = 0; j < 4; ++j) { TB[j] = acc[ai][bj][m][0][j] * TB[j] + acc[ai][bj][m][1][j]; TA[j] = acc[ai][bj][m][0][j] * TA[j]; } }
                    if (fr == (bj == 0 ? 15 : 0)) {
                        float2* dst = AGG + ((size_t)(b * 2 + bj) * NCH + cidx) * WR + ch;
                        *(f32x4*)(dst) = (f32x4){TA[0], TB[0], TA[1], TB[1]};
                        *(f32x4*)(dst + 2) = (f32x4){TA[2], TB[2], TA[3], TB[3]};
                    }
                } else {
                    f32x4 hin = *(const f32x4*)(CARRY + ((size_t)(b * 2 + bj) * 128 + (cidx - 4)) * WR + ch);
                    const int src = (lane & 48) | (bj == 0 ? 15 : 0);
#pragma unroll
                    for (int mm = 0; mm < 4; ++mm) { const int m = (bj == 0) ? mm : 3 - mm;
#pragma unroll
                        for (int j = 0; j < 4; ++j) { const float h = acc[ai][bj][m][1][j] + acc[ai][bj][m][0][j] * hin[j]; acc[ai][bj][m][1][j] = h; hin[j] = __shfl(h, src); } }
                }
            }
            if (PASS == 3) {
#pragma unroll
                for (int m = 0; m < 4; ++m) {
                    bf16_t* p = PX + (size_t)(row0 + m * 16 + fr) * NIN + OFF_RG + ch;
                    const u32x2 gv = *(const u32x2*)p;
                    const float y0 = acc[ai][0][m][1][0] + acc[ai][1][m][1][0], y1 = acc[ai][0][m][1][1] + acc[ai][1][m][1][1];
                    const float y2 = acc[ai][0][m][1][2] + acc[ai][1][m][1][2], y3 = acc[ai][0][m][1][3] + acc[ai][1][m][1][3];
                    u32x2 w; w.x = pk_bf16(bf_lo(gv.x) * y0, bf_hi(gv.x) * y1); w.y = pk_bf16(bf_lo(gv.y) * y2, bf_hi(gv.y) * y3);
                    *(u32x2*)p = w;
                }
            }
        }
        return true;
    }
};

__device__ __forceinline__ void transpose_tile(const float* __restrict__ src, int N, bf16_t* __restrict__ dst, int ldd, int koff, int kt, int nt, float* tile) {
    const int tid = threadIdx.x, k0 = kt * 64, n0 = nt * 64;
#pragma unroll
    for (int pass = 0; pass < 2; ++pass) {
        const int r = pass * 32 + (tid >> 4), c4 = (tid & 15) * 4;
        const f32x4 v = *(const f32x4*)(src + (size_t)(k0 + r) * N + n0 + c4);
        tile[r * 65 + c4 + 0] = v.x; tile[r * 65 + c4 + 1] = v.y; tile[r * 65 + c4 + 2] = v.z; tile[r * 65 + c4 + 3] = v.w;
    }
    __syncthreads();
    {
        const int n = tid >> 3, k8 = (tid & 7) * 8;
        float v[8];
#pragma unroll
        for (int i = 0; i < 8; ++i) v[i] = tile[(k8 + i) * 65 + n];
        u32x4 w; w.x = pk_bf16(v[0], v[1]); w.y = pk_bf16(v[2], v[3]); w.z = pk_bf16(v[4], v[5]); w.w = pk_bf16(v[6], v[7]);
        *(u32x4*)(dst + (size_t)(n0 + n) * ldd + koff + k0 + k8) = w;
    }
    __syncthreads();
}

__device__ __forceinline__ void phase_prep(const Params& p_unused, unsigned char* smem) {
    const Params p = load_params();
    unsigned char* ws = p.ws;
    float* tile = (float*)smem;
    const int tid = threadIdx.x, G = gridDim.x;
    for (int task = blockIdx.x; task < 4608; task += G) {
        int t = task;
        if (t < 1664) { transpose_tile(p.in[7], NIN, (bf16_t*)(ws + WS_WIN), 1024, 0, t / 104, t % 104, tile); continue; } t -= 1664;
        if (t < 320) { transpose_tile(p.in[18], 1024, (bf16_t*)(ws + WS_WPRG), 2304, 0, t / 16, t % 16, tile); continue; } t -= 320;
        if (t < 256) { transpose_tile(p.in[19], 1024, (bf16_t*)(ws + WS_WPRG), 2304, 1280, t / 16, t % 16, tile); continue; } t -= 256;
        if (t < 256) { transpose_tile(p.in[20], 1024, (bf16_t*)(ws + WS_WOUT), 1024, 0, t / 16, t % 16, tile); continue; } t -= 256;
        if (t < 1408) { transpose_tile(p.in[22], 5632, (bf16_t*)(ws + WS_WUP), 1024, 0, t / 88, t % 88, tile); continue; } t -= 1408;
        transpose_tile(p.in[25], 1024, (bf16_t*)(ws + WS_WDN), 2816, 0, t / 16, t % 16, tile);
    }
    {
        bf16_t* WG = (bf16_t*)(ws + WS_WG);
        const float* wa = p.in[11]; const float* wx = p.in[13];
        for (int e = blockIdx.x * 512 + tid; e < 20 * 256 * 256; e += G * 512) {
            const int jj0 = e & 63, k = (e >> 6) & 255, rest = e >> 14;
            const int gate = rest & 1, dir = (rest >> 1) & 1, pn = rest >> 2;
            const int head = pn >> 2, quarter = pn & 3;
            const float v = (gate ? wx : wa)[((size_t)(dir * 5 + head) * 256 + k) * 256 + quarter * 64 + jj0];
            const int wc = jj0 >> 4, fq = (jj0 >> 2) & 3, j = jj0 & 3;
            const int c = 128 * dir + 32 * wc + 16 * gate + 4 * fq + j;
            WG[((size_t)pn * 256 + c) * 256 + k] = (bf16_t)(pk_bf16(v, v) & 0xffffu);
        }
    }
    {
        bf16_t* WS_ = (bf16_t*)(ws + WS_WS); const float* w_s = p.in[16];
        for (int e = blockIdx.x * 512 + tid; e < 8 * 128 * 128 / 2; e += G * 512) ((unsigned*)WS_)[e] = pk_bf16(w_s[2 * e], w_s[2 * e + 1]);
    }
    {
        float* SPT = (float*)(ws + WS_SPT); const float* lam = p.in[10];
        for (int e = blockIdx.x * 512 + tid; e < 2 * WR; e += G * 512) SPT[e] = -8.0f * log1pf(expf(-lam[e]));
    }
    {
        const float* c = p.in[1]; const float* cctx = p.in[3]; const float* w_mod = p.in[4];
        float* MPART = (float*)(ws + WS_MPART);
        const int lane = tid & 63, wid = tid >> 6;
        for (int task = blockIdx.x * 8 + wid; task < 1536; task += G * 8) {
            const int cgp = task % 96, ks = task / 96, col = cgp * 64 + lane;
#define REP9(X) X(0) X(1) X(2) X(3) X(4) X(5) X(6) X(7) X(8)
#define GV_DECL(v) float sv##v, a9_##v = 0.f; { const float x = ((v) < 8) ? c[(v) * 1024 + ks * 64 + lane] : cctx[ks * 64 + lane]; sv##v = x / (1.0f + __expf(-x)); }
            REP9(GV_DECL)
#pragma unroll 8
            for (int kk = 0; kk < 64; ++kk) {
                const float w = w_mod[(size_t)(ks * 64 + kk) * 6144 + col];
#define GV_FMA(v) a9_##v += __int_as_float(__builtin_amdgcn_readlane(__float_as_int(sv##v), kk)) * w;
                REP9(GV_FMA)
            }
#define GV_ST(v) MPART[((size_t)ks * 9 + (v)) * 6144 + col] = a9_##v;
            REP9(GV_ST)
#undef GV_DECL
#undef GV_FMA
#undef GV_ST
        }
    }
}

__device__ __forceinline__ void row_norm_mod(const float* __restrict__ srow, bf16_t* __restrict__ drow, const float* gs, const float* sh, int lane) {
    const f32x4* s = (const f32x4*)srow;
    f32x4 a[4] = {s[lane * 2], s[lane * 2 + 1], s[128 + lane * 2], s[128 + lane * 2 + 1]};
    float ss = 0.f;
#pragma unroll
    for (int i = 0; i < 4; ++i) ss += a[i].x * a[i].x + a[i].y * a[i].y + a[i].z * a[i].z + a[i].w * a[i].w;
#pragma unroll
    for (int o = 32; o > 0; o >>= 1) ss += __shfl_xor(ss, o);
    const float rstd = rsqrtf(ss * (1.0f / 1024.0f) + 1e-6f);
#pragma unroll
    for (int hlf = 0; hlf < 2; ++hlf) {
        const int c0 = hlf * 512 + lane * 8;
        const f32x4 g0 = *(const f32x4*)(gs + c0), g1 = *(const f32x4*)(gs + c0 + 4), h0 = *(const f32x4*)(sh + c0), h1 = *(const f32x4*)(sh + c0 + 4);
        const f32x4 y0 = a[hlf * 2] * rstd * g0 + h0, y1 = a[hlf * 2 + 1] * rstd * g1 + h1;
        u32x4 w; w.x = pk_bf16(y0.x, y0.y); w.y = pk_bf16(y0.z, y0.w); w.z = pk_bf16(y1.x, y1.y); w.w = pk_bf16(y1.z, y1.w);
        *(u32x4*)(drow + c0) = w;
    }
}

template <bool FIRST> __device__ __forceinline__ void phase_norm(const Params& p_unused, unsigned char* smem) {
    const Params p = load_params();
    unsigned char* ws = p.ws;
    const int tid = threadIdx.x, lane = tid & 63, wid = tid >> 6, G = gridDim.x;
    float* gs = (float*)smem; float* sh = gs + 1024; float* gsc = sh + 1024; float* shc = gsc + 1024;
    const float* MPART = (const float*)(ws + WS_MPART); float* MFIN = (float*)(ws + WS_MFIN);
    const float* b_mod = p.in[5];
    const float* gn = FIRST ? p.in[6] : p.in[21];
    if (FIRST) {
        for (int e = blockIdx.x * 512 + tid; e < 9 * 6144; e += G * 512) {
            const int v = e / 6144, col = e % 6144; float s = b_mod[col];
#pragma unroll
            for (int ks = 0; ks < 16; ++ks) s += MPART[((size_t)ks * 9 + v) * 6144 + col];
            MFIN[e] = s;
        }
    }
    for (int grp = blockIdx.x; grp < 256; grp += G) {
        const int b = grp >> 5;
        __syncthreads();
        for (int e = tid; e < 2048; e += 512) {
            const int col = (FIRST ? 0 : 3 * 1024) + e;
            float s, sc = 0.f;
            if (FIRST) { s = b_mod[col]; sc = b_mod[col];
#pragma unroll
                for (int ks = 0; ks < 16; ++ks) { s += MPART[((size_t)ks * 9 + b) * 6144 + col]; sc += MPART[((size_t)ks * 9 + 8) * 6144 + col]; } }
            else s = MFIN[(size_t)b * 6144 + col];
            if (e < 1024) { sh[e] = s; if (FIRST) shc[e] = sc; }
            else { gs[e - 1024] = gn[e - 1024] * (1.0f + s); if (FIRST) gsc[e - 1024] = gn[e - 1024] * (1.0f + sc); }
        }
        __syncthreads();
        const float* src = FIRST ? p.in[0] : p.out;
        bf16_t* dst = FIRST ? (bf16_t*)p.out : (bf16_t*)(ws + WS_H2);
        for (int i = 0; i < 32; ++i) { const size_t row = (size_t)grp * 256 + wid * 32 + i; row_norm_mod(src + row * DM, dst + row * DM, gs, sh, lane); }
        if (FIRST) { const size_t crow = (size_t)grp * 8 + wid; row_norm_mod(p.in[2] + crow * DM, (bf16_t*)p.out + ((size_t)MROWS + crow) * DM, gsc, shc, lane); }
    }
}

__device__ __forceinline__ void phase_conv1d(const Params& p_unused) {
    const Params p = load_params();
    unsigned char* ws = p.ws;
    const bf16_t* PX = (const bf16_t*)(ws + WS_PX); const bf16_t* PC = (const bf16_t*)(ws + WS_PC);
    bf16_t* XR = (bf16_t*)p.out;
    const float* cw = p.in[8]; const float* cb = p.in[9];
    const size_t total = (size_t)(MROWS + MCTX) * 160, stride = (size_t)gridDim.x * 512;
    for (size_t it = (size_t)blockIdx.x * 512 + threadIdx.x; it < total; it += stride) {
        const int row = (int)(it / 160), ch = (int)(it % 160) * 8;
        const bf16_t* src; int ld, t, T;
        if (row < MROWS) { t = row & (SEQ - 1); T = SEQ; src = PX + (size_t)(row - t) * NIN; ld = NIN; }
        else { const int r2 = row - MROWS; t = r2 & (CTXL - 1); T = CTXL; src = PC + (size_t)(r2 - t) * WR; ld = WR; }
        f32x4 a0 = *(const f32x4*)(cb + ch), a1 = *(const f32x4*)(cb + ch + 4);
#pragma unroll
        for (int j = 0; j < 4; ++j) {
            const int tt = t + j - 2;
            if (tt >= 0 && tt < T) {
                const u32x4 v = *(const u32x4*)(src + (size_t)tt * ld + ch);
                const f32x4 w0 = *(const f32x4*)(cw + j * WR + ch), w1 = *(const f32x4*)(cw + j * WR + ch + 4);
                a0 += w0 * (f32x4){bf_lo(v.x), bf_hi(v.x), bf_lo(v.y), bf_hi(v.y)};
                a1 += w1 * (f32x4){bf_lo(v.z), bf_hi(v.z), bf_lo(v.w), bf_hi(v.w)};
            }
        }
        u32x4 w; w.x = pk_bf16(a0.x, a0.y); w.y = pk_bf16(a0.z, a0.w); w.z = pk_bf16(a1.x, a1.y); w.w = pk_bf16(a1.z, a1.w);
        *(u32x4*)(XR + (size_t)row * WR + ch) = w;
    }
}

__device__ __forceinline__ void phase_chunk_mlp(const Params& p_unused, unsigned char* smem) {
    const Params p = load_params();
    unsigned char* ws = p.ws;
    bf16_t* PX = (bf16_t*)(ws + WS_PX);
    const bf16_t* WSb = (const bf16_t*)(ws + WS_WS); const float* VSS = (const float*)(ws + WS_VSS);
    const float* g_v = p.in[15]; const float* b_s = p.in[17];
    constexpr int LDT = 136;
    bf16_t* Wl = (bf16_t*)smem; bf16_t* Vt = Wl + 128 * LDT; float* rs = (float*)(Vt + 128 * LDT);
    const int tid = threadIdx.x, lane = tid & 63, wid = tid >> 6, fr = lane & 15, fq = lane >> 4;
    for (int task = blockIdx.x; task < NB * 64 * 8; task += gridDim.x) {
        const int h = task & 7, n = (task >> 3) & 63, b = task >> 9;
        const size_t row0 = (size_t)b * SEQ + (size_t)n * 128;
        __syncthreads();
        if (tid < 128) { const f32x4* q = (const f32x4*)(VSS + (row0 + tid) * 16); const f32x4 s = q[0] + q[1] + q[2] + q[3]; rs[tid] = rsqrtf((s.x + s.y + s.z + s.w) * (1.0f / 1024.0f) + 1e-6f); }
#pragma unroll
        for (int i = 0; i < 4; ++i) { const int e = tid + i * 512, r = e >> 4, c8 = (e & 15) * 8;
            *(u32x4*)(Wl + r * LDT + c8) = *(const u32x4*)(WSb + (size_t)h * 16384 + r * 128 + c8); }
        __syncthreads();
#pragma unroll
        for (int i = 0; i < 4; ++i) { const int e = tid + i * 512, q = e >> 4, c8 = (e & 15) * 8;
            const u32x4 v = *(const u32x4*)(PX + (row0 + q) * NIN + OFF_V + h * 128 + c8);
            const float r = rs[q];
            const f32x4 g0 = *(const f32x4*)(g_v + h * 128 + c8), g1 = *(const f32x4*)(g_v + h * 128 + c8 + 4);
            const float f[8] = {bf_lo(v.x) * r * g0.x, bf_hi(v.x) * r * g0.y, bf_lo(v.y) * r * g0.z, bf_hi(v.y) * r * g0.w,
                                bf_lo(v.z) * r * g1.x, bf_hi(v.z) * r * g1.y, bf_lo(v.w) * r * g1.z, bf_hi(v.w) * r * g1.w};
#pragma unroll
            for (int k = 0; k < 8; k += 2) { const unsigned w = pk_bf16(f[k], f[k + 1]); Vt[(c8 + k) * LDT + q] = (bf16_t)(w & 0xffffu); Vt[(c8 + k + 1) * LDT + q] = (bf16_t)(w >> 16); }
        }
        __syncthreads();
        const int p0 = (wid >> 1) * 32, c0 = (wid & 1) * 64;
        f32x4 acc[2][4];
#pragma unroll
        for (int mi = 0; mi < 2; ++mi)
#pragma unroll
            for (int ni = 0; ni < 4; ++ni) acc[mi][ni] = (f32x4){0.f, 0.f, 0.f, 0.f};
#pragma unroll
        for (int kk = 0; kk < 4; ++kk) {
            bf16x8 af[2], bfv[4];
#pragma unroll
            for (int mi = 0; mi < 2; ++mi) af[mi] = *(const bf16x8*)(Wl + (p0 + mi * 16 + fr) * LDT + kk * 32 + fq * 8);
#pragma unroll
            for (int ni = 0; ni < 4; ++ni) bfv[ni] = *(const bf16x8*)(Vt + (c0 + ni * 16 + fr) * LDT + kk * 32 + fq * 8);
#pragma unroll
            for (int mi = 0; mi < 2; ++mi)
#pragma unroll
                for (int ni = 0; ni < 4; ++ni) acc[mi][ni] = __builtin_amdgcn_mfma_f32_16x16x32_bf16(bfv[ni], af[mi], acc[mi][ni], 0, 0, 0);
        }
#pragma unroll
        for (int mi = 0; mi < 2; ++mi) {
            const int pp = p0 + mi * 16 + fr; const float bias = b_s[pp * 8 + h];
#pragma unroll
            for (int ni = 0; ni < 4; ++ni) {
                bf16_t* up = PX + (row0 + pp) * NIN + OFF_U + h * 128 + c0 + ni * 16 + fq * 4;
                const u32x2 uv = *(const u32x2*)up;
                u32x2 w; w.x = pk_bf16(bf_lo(uv.x) * (acc[mi][ni].x + bias), bf_hi(uv.x) * (acc[mi][ni].y + bias));
                w.y = pk_bf16(bf_lo(uv.y) * (acc[mi][ni].z + bias), bf_hi(uv.y) * (acc[mi][ni].w + bias));
                *(u32x2*)up = w;
            }
        }
    }
}

__device__ __forceinline__ void phase_carry(const Params& p_unused) {
    const Params p = load_params();
    unsigned char* ws = p.ws;
    const float2* __restrict__ AGG = (const float2*)(ws + WS_AGG); float* __restrict__ CARRY = (float*)(ws + WS_CARRY);
    for (int idx = blockIdx.x * 512 + threadIdx.x; idx < NB * 2 * WR; idx += gridDim.x * 512) {
        const int ch = idx % WR, dir = (idx / WR) & 1, b = idx / (2 * WR);
        const float2* ag = AGG + (size_t)(b * 2 + dir) * NCH * WR + ch;
        float* cr = CARRY + (size_t)(b * 2 + dir) * 128 * WR + ch;
        float h = 0.f;
        if (dir == 0) {
#pragma unroll 4
            for (int ci = 0; ci < NCH; ++ci) { const float2 ab = ag[(size_t)ci * WR]; if (ci >= 4) cr[(size_t)(ci - 4) * WR] = h; h = ab.x * h + ab.y; }
        } else {
#pragma unroll 4
            for (int s = 0; s < NCH; ++s) { const int ci = s < 4 ? 3 - s : NCH + 3 - s; const float2 ab = ag[(size_t)ci * WR]; if (ci >= 4) cr[(size_t)(ci - 4) * WR] = h; h = ab.x * h + ab.y; }
        }
    }
}

__device__ __forceinline__ void phase_conv2d(const Params& p_unused) {
    const Params p = load_params();
    unsigned char* ws = p.ws;
    const bf16_t* UG = (const bf16_t*)(ws + WS_UG); bf16_t* UV = (bf16_t*)(ws + WS_UV);
    const float* cw = p.in[23]; const float* cb = p.in[24];
    const size_t total = (size_t)MROWS * 352, stride = (size_t)gridDim.x * 512;
    for (size_t it = (size_t)blockIdx.x * 512 + threadIdx.x; it < total; it += stride) {
        const int row = (int)(it / 352), ch = (int)(it % 352) * 8;
        const int t = row & (SEQ - 1), gi = t >> 6, gj = t & 63;
        f32x4 a0 = *(const f32x4*)(cb + ch), a1 = *(const f32x4*)(cb + ch + 4);
#pragma unroll
        for (int di = 0; di < 3; ++di)
#pragma unroll
            for (int dj = 0; dj < 3; ++dj) {
                const int ii = gi + di - 1, jj = gj + dj - 1;
                if (ii >= 0 && ii < 128 && jj >= 0 && jj < 64) {
                    const u32x4 v = *(const u32x4*)(UG + (size_t)(row + (di - 1) * 64 + (dj - 1)) * DFF + ch);
                    const f32x4 w0 = *(const f32x4*)(cw + (di * 3 + dj) * DFF + ch), w1 = *(const f32x4*)(cw + (di * 3 + dj) * DFF + ch + 4);
                    a0 += w0 * (f32x4){bf_lo(v.x), bf_hi(v.x), bf_lo(v.y), bf_hi(v.y)};
                    a1 += w1 * (f32x4){bf_lo(v.z), bf_hi(v.z), bf_lo(v.w), bf_hi(v.w)};
                }
            }
        bf16_t* up = UV + (size_t)row * DFF + ch;
        const u32x4 uv = *(const u32x4*)up;
        u32x4 w;
        w.x = pk_bf16(gelu_t(a0.x) * bf_lo(uv.x), gelu_t(a0.y) * bf_hi(uv.x)); w.y = pk_bf16(gelu_t(a0.z) * bf_lo(uv.y), gelu_t(a0.w) * bf_hi(uv.y));
        w.z = pk_bf16(gelu_t(a1.x) * bf_lo(uv.z), gelu_t(a1.y) * bf_hi(uv.z)); w.w = pk_bf16(gelu_t(a1.z) * bf_lo(uv.w), gelu_t(a1.w) * bf_hi(uv.w));
        *(u32x4*)up = w;
    }
}

__device__ __forceinline__ void phase_final(const Params& p_unused) {
    const Params p = load_params();
    const float* gf = p.in[26];
    const int lane = threadIdx.x & 63, wid = threadIdx.x >> 6;
    f32x4 g[4] = {*(const f32x4*)(gf + lane * 8), *(const f32x4*)(gf + lane * 8 + 4), *(const f32x4*)(gf + 512 + lane * 8), *(const f32x4*)(gf + 512 + lane * 8 + 4)};
    for (int row = blockIdx.x * 8 + wid; row < MROWS; row += gridDim.x * 8) {
        f32x4* s = (f32x4*)(p.out + (size_t)row * DM);
        f32x4 a[4] = {s[lane * 2], s[lane * 2 + 1], s[128 + lane * 2], s[128 + lane * 2 + 1]};
        float ss = 0.f;
#pragma unroll
        for (int i = 0; i < 4; ++i) ss += a[i].x * a[i].x + a[i].y * a[i].y + a[i].z * a[i].z + a[i].w * a[i].w;
#pragma unroll
        for (int o = 32; o > 0; o >>= 1) ss += __shfl_xor(ss, o);
        const float rstd = rsqrtf(ss * (1.0f / 1024.0f) + 1e-6f);
        s[lane * 2] = a[0] * rstd * g[0]; s[lane * 2 + 1] = a[1] * rstd * g[1]; s[128 + lane * 2] = a[2] * rstd * g[2]; s[128 + lane * 2 + 1] = a[3] * rstd * g[3];
    }
}

__global__ void __launch_bounds__(512, 2) mega(Params p) {
    extern __shared__ __attribute__((aligned(16))) unsigned char smem[];
    LAS unsigned char* lds = (LAS unsigned char*)smem;
    const int G = gridDim.x, c = blockIdx.x;
#ifndef PH_MASK
#define PH_MASK 0x3fff
#endif
#define IN(k) (((PH_MASK >> (k)) & 1) && p.ph_lo <= (k) && (k) < p.ph_hi)
#define SEAM(k) do { if (IN(k) && IN((k) + 1)) cg::this_grid().sync(); } while (0)

    if (IN(0)) phase_prep(p, smem);
    SEAM(0);
    if (IN(1)) phase_norm<true>(p, smem);
    SEAM(1);
    if (IN(2)) {
        __syncthreads();
        const Params q = load_params(); unsigned char* ws = q.ws; bf16_t* PX = (bf16_t*)(ws + WS_PX); float* MFIN = (float*)(ws + WS_MFIN); (void)PX; (void)MFIN;
        pg8::GemmD g{(const bf16_t*)q.out, (const bf16_t*)(ws + WS_WIN), DM, DM};
        SchedIn S{G, c}; EpiIn E{PX, (bf16_t*)(ws + WS_PC), (float*)(ws + WS_VSS)};
        pg8::gemm_phase(lds, g, S, E);
    }
    SEAM(2);
    if (IN(3)) { phase_conv1d(p); phase_chunk_mlp(p, smem); }
    SEAM(3);
    if (IN(4)) {
        __syncthreads();
        const Params q = load_params(); unsigned char* ws = q.ws; bf16_t* PX = (bf16_t*)(ws + WS_PX); float* MFIN = (float*)(ws + WS_MFIN); (void)PX; (void)MFIN;
        pg8::GemmD g{(const bf16_t*)q.out, (const bf16_t*)(ws + WS_WG), WR, 256};
        SchedGate S{264, 264 * 20, G, c};
        EpiGate<1> E{(const bf16_t*)q.out, q.in[12], q.in[14], (const float*)(ws + WS_SPT), (float2*)(ws + WS_AGG), (const float*)(ws + WS_CARRY), PX};
        pg8::gemm_phase(lds, g, S, E);
    }
    SEAM(4);
    if (IN(5)) phase_carry(p);
    SEAM(5);
    if (IN(6)) {
        __syncthreads();
        const Params q = load_params(); unsigned char* ws = q.ws; bf16_t* PX = (bf16_t*)(ws + WS_PX); float* MFIN = (float*)(ws + WS_MFIN); (void)PX; (void)MFIN;
        pg8::GemmD g{(const bf16_t*)q.out, (const bf16_t*)(ws + WS_WG), WR, 256};
        SchedGate S{256, 256 * 20, G, c};
        EpiGate<3> E{(const bf16_t*)q.out, q.in[12], q.in[14], (const float*)(ws + WS_SPT), (float2*)(ws + WS_AGG), (const float*)(ws + WS_CARRY), PX};
        pg8::gemm_phase(lds, g, S, E);
    }
    SEAM(6);
    if (IN(7)) {
        __syncthreads();
        const Params q = load_params(); unsigned char* ws = q.ws; bf16_t* PX = (bf16_t*)(ws + WS_PX); float* MFIN = (float*)(ws + WS_MFIN); (void)PX; (void)MFIN;
        pg8::GemmD g{PX + OFF_RG, (const bf16_t*)(ws + WS_WPRG), NIN, 2304};
        SchedMerge S{G, c}; EpiMerge E{PX};
        pg8::gemm_phase(lds, g, S, E);
    }
    SEAM(7);
    if (IN(8)) {
        __syncthreads();
        const Params q = load_params(); unsigned char* ws = q.ws; bf16_t* PX = (bf16_t*)(ws + WS_PX); float* MFIN = (float*)(ws + WS_MFIN); (void)PX; (void)MFIN;
        pg8::GemmD g{PX, (const bf16_t*)(ws + WS_WOUT), NIN, DM};
        SchedPlain S{256, 4, 1024, G, c, 16}; EpiRes E{q.in[0], q.out, MFIN + 2 * 1024};
        pg8::gemm_phase(lds, g, S, E);
    }
    SEAM(8);
    if (IN(9)) phase_norm<false>(p, smem);
    SEAM(9);
    if (IN(10)) {
        __syncthreads();
        const Params q = load_params(); unsigned char* ws = q.ws; bf16_t* PX = (bf16_t*)(ws + WS_PX); float* MFIN = (float*)(ws + WS_MFIN); (void)PX; (void)MFIN;
        pg8::GemmD g{(const bf16_t*)(ws + WS_H2), (const bf16_t*)(ws + WS_WUP), DM, DM};
        SchedPlain S{256, 22, 5632, G, c, 16}; EpiUp E{(bf16_t*)(ws + WS_UG), (bf16_t*)(ws + WS_UV)};
        pg8::gemm_phase(lds, g, S, E);
    }
    SEAM(10);
    if (IN(11)) phase_conv2d(p);
    SEAM(11);
    if (IN(12)) {
        __syncthreads();
        const Params q = load_params(); unsigned char* ws = q.ws; bf16_t* PX = (bf16_t*)(ws + WS_PX); float* MFIN = (float*)(ws + WS_MFIN); (void)PX; (void)MFIN;
        pg8::GemmD g{(const bf16_t*)(ws + WS_UV), (const bf16_t*)(ws + WS_WDN), DFF, DFF};
        SchedPlain S{256, 4, 1024, G, c, 44}; EpiRes E{q.out, q.out, MFIN + 5 * 1024};
        pg8::gemm_phase(lds, g, S, E);
    }
    SEAM(12);
    if (IN(13)) phase_final(p);
}

extern "C" void kernel_launch(void* const* d_in, const int* in_sizes, int n_in, void* d_out, int out_size, void* d_ws, size_t ws_size, hipStream_t stream) {
    static int grid = 0;
    if (grid == 0) {
        if (n_in != 27 || ws_size < WS_END) { fprintf(stderr, "kernel_launch: unexpected n_in %d / ws %zu (need %zu)\n", n_in, ws_size, (size_t)WS_END); grid = -1; return; }
        int dev = 0, cus = 0, per_cu = 0;
        hipGetDevice(&dev); hipDeviceGetAttribute(&cus, hipDeviceAttributeMultiprocessorCount, dev);
        if (hipFuncSetAttribute((const void*)mega, hipFuncAttributeMaxDynamicSharedMemorySize, LDS_BYTES) != hipSuccess) { fprintf(stderr, "kernel_launch: hipFuncSetAttribute failed\n"); grid = -1; return; }
        hipOccupancyMaxActiveBlocksPerMultiprocessor(&per_cu, (const void*)mega, 512, LDS_BYTES);
        (void)hipGetLastError();
        if (per_cu < 1) fprintf(stderr, "kernel_launch: occupancy query says %d blocks/CU\n", per_cu);
        grid = cus > 0 ? cus : 256;
    }
    if (grid < 0) return;
    Params p{};
    for (int i = 0; i < 27; ++i) p.in[i] = (const float*)d_in[i];
    p.out = (float*)d_out; p.ws = (unsigned char*)d_ws;
#if ONE_LAUNCH
    p.ph_lo = 0; p.ph_hi = NPH;
    void* args[] = {&p};
    hipError_t e = hipLaunchCooperativeKernel((const void*)mega, dim3(grid), dim3(512), args, LDS_BYTES, stream);
    if (e != hipSuccess) fprintf(stderr, "cooperative launch failed: %s (grid %d)\n", hipGetErrorString(e), grid);
#else
    for (int ph = 0; ph < NPH; ++ph) { p.ph_lo = ph; p.ph_hi = ph + 1; hipLaunchKernelGGL(mega, dim3(grid), dim3(512), LDS_BYTES, stream, p); }
#endif
}
```

```cpp
#include <hip/hip_runtime.h>
#include <hip/hip_cooperative_groups.h>
#include <cstdio>
namespace cg = cooperative_groups;

#ifndef ONE_LAUNCH
#define ONE_LAUNCH 1
#endif

#define LAS __attribute__((address_space(3)))
typedef unsigned short bf16_t;
typedef short bf16x8 __attribute__((ext_vector_type(8)));
typedef float f32x4 __attribute__((ext_vector_type(4)));
typedef unsigned u32x4 __attribute__((ext_vector_type(4)));
typedef unsigned u32x2 __attribute__((ext_vector_type(2)));

constexpr int DM = 1024, NB = 8, SEQ = 8192, CTXL = 256, WR = 1280, NIN = 6656, DFF = 2816;
constexpr int MROWS = NB * SEQ;
constexpr int MCTX = NB * CTXL;
constexpr int NCH = 132;
constexpr int NPH = 14;
constexpr int LDS_BYTES = 131072 + 256;

constexpr size_t al256(size_t x) { return (x + 255) & ~(size_t)255; }
constexpr size_t WS_WIN = 0;
constexpr size_t WS_WG = WS_WIN + al256((size_t)NIN * DM * 2);
constexpr size_t WS_WPRG = WS_WG + al256((size_t)20 * 256 * 256 * 2);
constexpr size_t WS_WOUT = WS_WPRG + al256((size_t)1024 * 2304 * 2);
constexpr size_t WS_WUP = WS_WOUT + al256((size_t)1024 * 1024 * 2);
constexpr size_t WS_WDN = WS_WUP + al256((size_t)5632 * 1024 * 2);
constexpr size_t WS_WS = WS_WDN + al256((size_t)1024 * 2816 * 2);
constexpr size_t WS_MPART = WS_WS + al256((size_t)8 * 128 * 128 * 2);
constexpr size_t WS_MFIN = WS_MPART + al256((size_t)16 * 9 * 6144 * 4);
constexpr size_t WS_VSS = WS_MFIN + al256((size_t)9 * 6144 * 4);
constexpr size_t WS_AGG = WS_VSS + al256((size_t)MROWS * 16 * 4);
constexpr size_t WS_CARRY = WS_AGG + al256((size_t)NB * 2 * NCH * WR * 8);
constexpr size_t WS_PC = WS_CARRY + al256((size_t)NB * 2 * 128 * WR * 4);
constexpr size_t WS_SPT = WS_PC + al256((size_t)MCTX * WR * 2);
constexpr size_t WS_BAR = WS_SPT + al256((size_t)6 * WR * 4);
constexpr size_t WS_PX = WS_BAR + al256((size_t)3456 * 4);
constexpr size_t WS_END = WS_PX + (size_t)MROWS * NIN * 2;
constexpr size_t WS_H2 = WS_PX;
constexpr size_t WS_UG = WS_H2 + (size_t)MROWS * DM * 2;
constexpr size_t WS_UV = WS_UG + (size_t)MROWS * DFF * 2;
static_assert(WS_UV + (size_t)MROWS * DFF * 2 <= WS_END, "ffn buffers fit in px region");
static_assert(WS_H2 + (size_t)MROWS * DM * 2 <= WS_UV, "x2 (bf16) must not overlap the act buffer");
constexpr size_t WS_G3A = WS_END;
constexpr size_t G3_HALF_BYTES = (size_t)32768 * WR * 2;
constexpr size_t WS_NEED = WS_G3A + G3_HALF_BYTES;
constexpr size_t OUT_G3B = (size_t)(MROWS + MCTX) * WR * 2;
static_assert(OUT_G3B % 256 == 0 && OUT_G3B + G3_HALF_BYTES <= (size_t)MROWS * DM * 4, "g3 tail fits in d_out");
static_assert(WS_NEED <= (size_t)1073741824, "workspace fits");

constexpr int OFF_RG = 1280, OFF_U = 2560, OFF_V = 3584, OFF_GR = 4608, OFF_GG = 5632;

struct Params {
    const float* in[27];
    float* out;
    unsigned char* ws;
    int ph_lo, ph_hi;
};

__device__ __forceinline__ Params load_params() {
    const __attribute__((address_space(4))) unsigned long long* k = (const __attribute__((address_space(4))) unsigned long long*)__builtin_amdgcn_kernarg_segment_ptr();
    asm volatile("" : "+s"(k));
    Params q;
#pragma unroll
    for (int i = 0; i < 27; ++i) q.in[i] = (const float*)k[i];
    q.out = (float*)k[27]; q.ws = (unsigned char*)k[28]; q.ph_lo = 0; q.ph_hi = 0;
    return q;
}

__device__ __forceinline__ unsigned pk_bf16(float lo, float hi) { unsigned r; asm("v_cvt_pk_bf16_f32 %0, %1, %2" : "=v"(r) : "v"(lo), "v"(hi)); return r; }
__device__ __forceinline__ float bf_lo(unsigned w) { return __uint_as_float(w << 16); }
__device__ __forceinline__ float bf_hi(unsigned w) { return __uint_as_float(w & 0xffff0000u); }
__device__ __forceinline__ float sigmoidf_(float x) { return __builtin_amdgcn_rcpf(1.0f + __expf(-x)); }
__device__ __forceinline__ float gelu_t(float x) { return x * sigmoidf_(1.5957691216057308f * (x + 0.044715f * x * x * x)); }
typedef float f32x2 __attribute__((ext_vector_type(2)));
__device__ __forceinline__ f32x2 gelu_pk2(f32x2 x) {
    const f32x2 t = x * x;
    const f32x2 u = x * (t * (-0.044715f * 1.5957691216057308f * 1.4426950408889634f) + (-1.5957691216057308f * 1.4426950408889634f));
    f32x2 e; e.x = __builtin_amdgcn_exp2f(u.x); e.y = __builtin_amdgcn_exp2f(u.y);
    const f32x2 d = e + 1.0f;
    f32x2 r; r.x = __builtin_amdgcn_rcpf(d.x); r.y = __builtin_amdgcn_rcpf(d.y);
    return x * r;
}
__device__ __forceinline__ f32x2 sigmoid_pk2(f32x2 x) {
    const f32x2 u = x * (-1.4426950408889634f);
    f32x2 e; e.x = __builtin_amdgcn_exp2f(u.x); e.y = __builtin_amdgcn_exp2f(u.y);
    const f32x2 d = e + 1.0f;
    f32x2 r; r.x = __builtin_amdgcn_rcpf(d.x); r.y = __builtin_amdgcn_rcpf(d.y);
    return r;
}
struct Em1K { float c3, c4, c5, c6; };
__device__ __forceinline__ Em1K em1k_make() { Em1K k{0.16666667f, 0.041666668f, 0.008333334f, 0.0013888889f}; asm volatile("" : "+v"(k.c3), "+v"(k.c4), "+v"(k.c5), "+v"(k.c6)); return k; }
__device__ __forceinline__ float em1fk(float x, const Em1K& k) {
    const float p = x * (1.0f + x * (0.5f + x * (k.c3 + x * (k.c4 + x * (k.c5 + x * k.c6)))));
    return (__builtin_fabsf(x) < 0.25f) ? p : (__expf(x) - 1.0f);
}
__device__ __forceinline__ float em1f(float x) {
    const float p = x * (1.0f + x * (0.5f + x * (0.16666667f + x * (0.041666668f + x * (0.008333334f + x * 0.0013888889f)))));
    return (__builtin_fabsf(x) < 0.25f) ? p : (__expf(x) - 1.0f);
}
#define DPPF(old, src, ctrl) __int_as_float(__builtin_amdgcn_update_dpp(__float_as_int(old), __float_as_int(src), (ctrl), 0xf, 0xf, false))

#define SCAN_STEP(dir, n) \
    "v_fmac_f32_dpp %4, %4, %0 " dir ":" #n " row_mask:0xf bank_mask:0xf\n" \
    "v_fmac_f32_dpp %5, %5, %1 " dir ":" #n " row_mask:0xf bank_mask:0xf\n" \
    "v_fmac_f32_dpp %6, %6, %2 " dir ":" #n " row_mask:0xf bank_mask:0xf\n" \
    "v_fmac_f32_dpp %7, %7, %3 " dir ":" #n " row_mask:0xf bank_mask:0xf\n" \
    "v_mul_f32_dpp %0, %0, %0 " dir ":" #n " row_mask:0xf bank_mask:0xf\n" \
    "v_mul_f32_dpp %1, %1, %1 " dir ":" #n " row_mask:0xf bank_mask:0xf\n" \
    "v_mul_f32_dpp %2, %2, %2 " dir ":" #n " row_mask:0xf bank_mask:0xf\n" \
    "v_mul_f32_dpp %3, %3, %3 " dir ":" #n " row_mask:0xf bank_mask:0xf\n"
__device__ __forceinline__ void row_scan4_fwd(float& a0, float& a1, float& a2, float& a3, float& b0, float& b1, float& b2, float& b3) {
    asm volatile("s_nop 1\n" SCAN_STEP("row_shr", 1) SCAN_STEP("row_shr", 2) SCAN_STEP("row_shr", 4) SCAN_STEP("row_shr", 8)
                 : "+v"(a0), "+v"(a1), "+v"(a2), "+v"(a3), "+v"(b0), "+v"(b1), "+v"(b2), "+v"(b3));
}
__device__ __forceinline__ void row_scan4_bwd(float& a0, float& a1, float& a2, float& a3, float& b0, float& b1, float& b2, float& b3) {
    asm volatile("s_nop 1\n" SCAN_STEP("row_shl", 1) SCAN_STEP("row_shl", 2) SCAN_STEP("row_shl", 4) SCAN_STEP("row_shl", 8)
                 : "+v"(a0), "+v"(a1), "+v"(a2), "+v"(a3), "+v"(b0), "+v"(b1), "+v"(b2), "+v"(b3));
}

namespace pg8 {
constexpr int BM = 256, BK = 64, HALF = 128, HTB = HALF * BK * 2, NXCD = 8, WGM = 8;
__device__ __forceinline__ int lds_byte(int r, int c) { const int st = (r >> 4) * 2 + (c >> 5), rr = r & 15, cc = c & 31, ob = rr * 64 + cc * 2; return st * 1024 + (ob ^ (((ob >> 9) & 1) << 5)); }
__device__ __forceinline__ void stage_rc(int b, int& R, int& C) { const int st = b / 1024, sb = b % 1024, swz = sb ^ (((sb >> 9) & 1) << 5); R = (st >> 1) * 16 + swz / 64; C = (st & 1) * 32 + (swz % 64) / 2; }
__device__ __forceinline__ int perm32(int rho) { const int n = rho >> 4, i = rho & 15; return 8 * (i >> 2) + 4 * n + (i & 3); }

struct Unit { int pm, pn, ka0, kb0, nkt, tag; };
struct GemmD { const bf16_t* A; const bf16_t* Bt; int lda, ldb; };

__device__ __forceinline__ void tile_map(int L, int nM, int nN, int nwg, int& pm, int& pn) {
    int wgid = L; { const int q = nwg / NXCD, r = nwg % NXCD, xcd = wgid % NXCD, off = wgid / NXCD; wgid = (xcd < r ? xcd * (q + 1) : r * (q + 1) + (xcd - r) * q) + off; }
    const int nig = WGM * nN, gid = wgid / nig, fm = gid * WGM, gsz = (nM - fm) < WGM ? (nM - fm) : WGM;
    pm = fm + ((wgid % nig) % gsz); pn = (wgid % nig) / gsz;
}

template <class Epi, class Sched, bool ALIGN_EPI = true, bool SP2 = true>
__device__ __forceinline__ void gemm_phase(LAS unsigned char* lds, const GemmD g, const Sched& S, const Epi& E) {
    const int tid = threadIdx.x, wid = __builtin_amdgcn_readfirstlane(tid >> 6), lane = tid & 63, wr = wid >> 2, wc = wid & 3, fr = lane & 15, fq = lane >> 4;
    unsigned voffA[2], voffB[2];
#pragma unroll
    for (int i = 0; i < 2; ++i) { int R, C; stage_rc(tid * 16 + i * 8192, R, C); const int Rb = Epi::PERM ? ((R & ~31) + perm32(R & 31)) : R;
        voffA[i] = (unsigned)(R * g.lda + C) * 2u; voffB[i] = (unsigned)(Rb * g.ldb + C) * 2u; }
    const size_t kstep = (size_t)(BK * 2);
    const size_t hstepA = (size_t)HALF * g.lda * 2, hstepB = (size_t)HALF * g.ldb * 2;
    const unsigned ldsw = (unsigned)wid * 1024u;
    const int aoff = lds_byte(wr * 64 + fr, fq * 8), boff = lds_byte(wc * 32 + fr, fq * 8);
#define PG8_SA(b, h) (((b) * 2 + (h)) * HTB)
#define PG8_SB(b, h) ((4 + (b) * 2 + (h)) * HTB)
#define PG8_STAGE(bufoff, gbase, voff) do { _Pragma("unroll") for (int _i = 0; _i < 2; ++_i) \
        __builtin_amdgcn_global_load_lds((const unsigned*)((const char*)(gbase) + (voff)[_i]), (LAS unsigned*)(lds + (bufoff) + ldsw + _i * 8192), 16, 0, 0); } while (0)
#define PG8_LDA(dst, b, h) do { _Pragma("unroll") for (int m = 0; m < 4; ++m) _Pragma("unroll") for (int k = 0; k < 2; ++k) dst[m][k] = *(const LAS bf16x8*)(lds + PG8_SA(b, h) + aoff + m * 2048 + k * 1024); } while (0)
#define PG8_LDB(dst, b, h) do { _Pragma("unroll") for (int n = 0; n < 2; ++n) _Pragma("unroll") for (int k = 0; k < 2; ++k) dst[n][k] = *(const LAS bf16x8*)(lds + PG8_SB(b, h) + boff + n * 2048 + k * 1024); } while (0)
#define PG8_MMA(ai, bj, At, Bt) do { __builtin_amdgcn_s_setprio(1); _Pragma("unroll") for (int m = 0; m < 4; ++m) _Pragma("unroll") for (int n = 0; n < 2; ++n) _Pragma("unroll") for (int k = 0; k < 2; ++k) \
        acc[ai][bj][m][n] = __builtin_amdgcn_mfma_f32_16x16x32_bf16(Bt[n][k], At[m][k], acc[ai][bj][m][n], 0, 0, 0); __builtin_amdgcn_s_setprio(0); } while (0)
#define PG8_WAIT_V(n) asm volatile("s_waitcnt vmcnt(" #n ")" ::: "memory")
#define PG8_WAIT_L(n) asm volatile("s_waitcnt lgkmcnt(" #n ")" ::: "memory")
#define PG8_BAR __builtin_amdgcn_s_barrier()
#define PG8_SCHED __builtin_amdgcn_sched_barrier(0)
    Unit cur, nxt; int ui = 0;
    if (!S.next(0, cur)) return;
    f32x4 acc[2][2][4][2];
#pragma unroll
    for (int a = 0; a < 2; ++a)
#pragma unroll
        for (int b = 0; b < 2; ++b)
#pragma unroll
            for (int m = 0; m < 4; ++m)
#pragma unroll
                for (int n = 0; n < 2; ++n) acc[a][b][m][n] = (f32x4){0.f, 0.f, 0.f, 0.f};
    bf16x8 At[4][2], B0[2][2], B1[2][2];
    typename Epi::Pre pre;
    E.prefetch(pre, cur, wr, wc, fr, fq);
    const char* cA = (const char*)g.A + (size_t)cur.pm * 2 * hstepA + (size_t)cur.ka0 * kstep;
    const char* cB = (const char*)g.Bt + (size_t)cur.pn * 2 * hstepB + (size_t)cur.kb0 * kstep;
    if constexpr (SP2) {
        PG8_STAGE(PG8_SB(0, 0), cB, voffB); PG8_STAGE(PG8_SB(0, 1), cB + hstepB, voffB); PG8_STAGE(PG8_SA(0, 0), cA, voffA); PG8_STAGE(PG8_SA(0, 1), cA + hstepA, voffA);
        if (wr == 1) PG8_BAR;
        PG8_WAIT_V(2); PG8_BAR;
        PG8_STAGE(PG8_SB(1, 0), cB + kstep, voffB); PG8_STAGE(PG8_SA(1, 0), cA + kstep, voffA); PG8_STAGE(PG8_SB(1, 1), cB + hstepB + kstep, voffB);
        PG8_WAIT_V(6); PG8_BAR;
    } else {
        PG8_STAGE(PG8_SB(0, 0), cB, voffB); PG8_STAGE(PG8_SA(0, 0), cA, voffA); PG8_STAGE(PG8_SB(0, 1), cB + hstepB, voffB); PG8_STAGE(PG8_SA(0, 1), cA + hstepA, voffA);
        if (wr == 1) PG8_BAR;
        PG8_WAIT_V(4); PG8_BAR;
        PG8_STAGE(PG8_SB(1, 0), cB + kstep, voffB); PG8_STAGE(PG8_SA(1, 0), cA + kstep, voffA); PG8_STAGE(PG8_SB(1, 1), cB + hstepB + kstep, voffB);
        PG8_WAIT_V(6); PG8_BAR;
    }
    for (;;) {
        const bool has_next = S.next(ui + 1, nxt);
        const char* nA = has_next ? (const char*)g.A + (size_t)nxt.pm * 2 * hstepA + (size_t)nxt.ka0 * kstep : cA;
        const char* nB = has_next ? (const char*)g.Bt + (size_t)nxt.pn * 2 * hstepB + (size_t)nxt.kb0 * kstep : cB;
        const int nt = cur.nkt;
#pragma unroll 1
        for (int t = 0; t < nt; t += 2) {
            const bool last = (t == nt - 2);
            const char* a1 = cA + (size_t)(t + 1) * kstep;
            const char* a2 = last ? nA : cA + (size_t)(t + 2) * kstep; const char* b2 = last ? nB : cB + (size_t)(t + 2) * kstep;
            const char* a3 = a2 + kstep; const char* b3 = b2 + kstep;
            if constexpr (SP2) {
            PG8_LDB(B0, 0, 0); PG8_LDB(B1, 0, 1); PG8_SCHED; PG8_LDA(At, 0, 0); PG8_STAGE(PG8_SA(1, 1), a1 + hstepA, voffA);
            PG8_WAIT_V(8); PG8_WAIT_L(0); PG8_BAR; PG8_MMA(0, 0, At, B0); PG8_MMA(0, 1, At, B1); PG8_BAR; PG8_SCHED;
            PG8_LDA(At, 0, 1); PG8_STAGE(PG8_SB(0, 0), b2, voffB); PG8_STAGE(PG8_SB(0, 1), b2 + hstepB, voffB); PG8_STAGE(PG8_SA(0, 0), a2, voffA);
            PG8_WAIT_V(8); PG8_WAIT_L(0); PG8_BAR; PG8_MMA(1, 0, At, B0); PG8_MMA(1, 1, At, B1); PG8_BAR; PG8_SCHED;
            PG8_LDB(B0, 1, 0); PG8_LDB(B1, 1, 1); PG8_SCHED; PG8_LDA(At, 1, 0); PG8_STAGE(PG8_SA(0, 1), a2 + hstepA, voffA);
            PG8_WAIT_V(8); PG8_WAIT_L(0); PG8_BAR; PG8_MMA(0, 0, At, B0); PG8_MMA(0, 1, At, B1); PG8_BAR; PG8_SCHED;
            PG8_LDA(At, 1, 1); PG8_STAGE(PG8_SB(1, 0), b3, voffB); PG8_STAGE(PG8_SB(1, 1), b3 + hstepB, voffB); PG8_STAGE(PG8_SA(1, 0), a3, voffA);
            PG8_WAIT_V(8); PG8_WAIT_L(0); PG8_BAR; PG8_MMA(1, 0, At, B0); PG8_MMA(1, 1, At, B1); PG8_BAR; PG8_SCHED;
            } else {
            PG8_LDB(B0, 0, 0); PG8_SCHED; PG8_LDA(At, 0, 0); PG8_STAGE(PG8_SA(1, 1), a1 + hstepA, voffA);
            PG8_WAIT_L(8); PG8_BAR; PG8_WAIT_L(0); PG8_MMA(0, 0, At, B0); PG8_BAR; PG8_SCHED;
            PG8_LDB(B1, 0, 1); PG8_STAGE(PG8_SB(0, 0), b2, voffB);
            PG8_BAR; PG8_WAIT_L(0); PG8_MMA(0, 1, At, B1); PG8_BAR;
            PG8_LDA(At, 0, 1); PG8_STAGE(PG8_SA(0, 0), a2, voffA);
            PG8_BAR; PG8_WAIT_L(0); PG8_MMA(1, 0, At, B0); PG8_BAR; PG8_SCHED;
            PG8_STAGE(PG8_SB(0, 1), b2 + hstepB, voffB);
            PG8_WAIT_V(6); PG8_BAR; PG8_MMA(1, 1, At, B1); PG8_BAR;
            PG8_LDB(B0, 1, 0); PG8_SCHED; PG8_LDA(At, 1, 0); PG8_STAGE(PG8_SA(0, 1), a2 + hstepA, voffA);
            PG8_WAIT_L(8); PG8_BAR; PG8_WAIT_L(0); PG8_MMA(0, 0, At, B0); PG8_BAR; PG8_SCHED;
            PG8_LDB(B1, 1, 1); PG8_STAGE(PG8_SB(1, 0), b3, voffB);
            PG8_BAR; PG8_WAIT_L(0); PG8_MMA(0, 1, At, B1); PG8_BAR;
            PG8_LDA(At, 1, 1); PG8_STAGE(PG8_SA(1, 0), a3, voffA);
            PG8_BAR; PG8_WAIT_L(0); PG8_MMA(1, 0, At, B0); PG8_BAR; PG8_SCHED;
            PG8_STAGE(PG8_SB(1, 1), b3 + hstepB, voffB);
            PG8_WAIT_V(6); PG8_BAR; PG8_MMA(1, 1, At, B1); PG8_BAR;
            }
        }
        if constexpr (ALIGN_EPI) { if (wr == 0) PG8_BAR; }
        int efr = fr, efq = fq; asm volatile("" : "+v"(efr), "+v"(efq));
        const bool zero = E(acc, cur, wr, wc, efr, efq, pre);
        if (has_next) E.prefetch(pre, nxt, wr, wc, efr, efq);
        if (!has_next) break;
        if (zero) {
#pragma unroll
            for (int a = 0; a < 2; ++a)
#pragma unroll
                for (int b = 0; b < 2; ++b)
#pragma unroll
                    for (int m = 0; m < 4; ++m)
#pragma unroll
                        for (int n = 0; n < 2; ++n) acc[a][b][m][n] = (f32x4){0.f, 0.f, 0.f, 0.f};
        }
        cur = nxt; cA = nA; cB = nB; ++ui;
        if constexpr (ALIGN_EPI) { if (wr == 1) PG8_BAR; }
    }
    PG8_WAIT_V(0);
    if constexpr (!ALIGN_EPI) { if (wr == 0) PG8_BAR; }
    PG8_BAR;
#undef PG8_SA
#undef PG8_SB
#undef PG8_STAGE
#undef PG8_LDA
#undef PG8_LDB
#undef PG8_MMA
#undef PG8_WAIT_V
#undef PG8_WAIT_L
#undef PG8_BAR
#undef PG8_SCHED
}
}
using pg8::Unit;

struct SchedPlain {
    int nM, nN, nwg, G, c, nkt;
    __device__ __forceinline__ bool next(int i, Unit& u) const {
        const long L = (long)i * G + c; if (L >= nwg) return false;
        pg8::tile_map((int)L, nM, nN, nwg, u.pm, u.pn); u.ka0 = 0; u.kb0 = 0; u.nkt = nkt; u.tag = 0; return true; }
};
struct SchedIn {
    int G, c;
    __device__ __forceinline__ bool next(int i, Unit& u) const {
        const long L = (long)i * G + c; if (L >= 6656 + 40) return false;
        if (L < 6656) pg8::tile_map((int)L, 256, 26, 6656, u.pm, u.pn);
        else { const int e = (int)L - 6656; u.pm = 256 + e / 5; u.pn = e % 5; }
        u.ka0 = 0; u.kb0 = 0; u.nkt = 16; u.tag = 0; return true; }
};
struct SchedMerge {
    int G, c;
    __device__ __forceinline__ bool next(int i, Unit& u) const {
        const long L = (long)(i >> 1) * G + c; if (L >= 1024) return false;
        pg8::tile_map((int)L, 256, 4, 1024, u.pm, u.pn); const int part = i & 1;
        u.ka0 = part ? 20 : 0; u.kb0 = u.ka0; u.nkt = part ? 16 : 20; u.tag = part; return true; }
};
struct SchedGate {
    int nM, nwg, G, c;
    __device__ __forceinline__ bool next(int i, Unit& u) const {
        const long L = (long)i * G + c; if (L >= nwg) return false;
        pg8::tile_map((int)L, nM, 20, nwg, u.pm, u.pn); u.ka0 = (u.pn >> 2) * 4; u.kb0 = 0; u.nkt = 4; u.tag = 0; return true; }
};

struct EpiIn {
    static constexpr bool PERM = true;
    bf16_t* PX; bf16_t* PC; float* VSS;
    struct Pre {}; __device__ __forceinline__ void prefetch(Pre&, const Unit&, int, int, int, int) const {}
    __device__ __forceinline__ bool operator()(f32x4 (&acc)[2][2][4][2], const Unit& u, int wr, int wc, int fr, int fq, const Pre& pre) const {
        const int pn = u.pn;
        const int mode = (u.pm >= 256) ? 0 : ((pn >= 5 && pn < 10) ? 1 : ((pn >= 14 && pn < 18) ? 2 : 0));
#pragma unroll
        for (int ai = 0; ai < 2; ++ai)
#pragma unroll
            for (int m = 0; m < 4; ++m) {
                const int r = u.pm * 256 + ai * 128 + wr * 64 + m * 16 + fr;
                float ss = 0.f;
#pragma unroll
                for (int bj = 0; bj < 2; ++bj) {
                    const int c0 = pn * 256 + bj * 128 + wc * 32 + fq * 8;
                    f32x2 v2[4];
#pragma unroll
                    for (int n = 0; n < 2; ++n)
#pragma unroll
                        for (int jp = 0; jp < 2; ++jp) {
                            f32x2 x = {acc[ai][bj][m][n][2 * jp], acc[ai][bj][m][n][2 * jp + 1]};
                            if (mode == 1 || mode == 2) x = gelu_pk2(x);
                            else if (mode == 3) x = sigmoid_pk2(x);
                            if (mode == 2) ss += x.x * x.x + x.y * x.y;
                            v2[n * 2 + jp] = x;
                        }
                    const float v[8] = {v2[0].x, v2[0].y, v2[1].x, v2[1].y, v2[2].x, v2[2].y, v2[3].x, v2[3].y};
                    u32x4 w; w.x = pk_bf16(v[0], v[1]); w.y = pk_bf16(v[2], v[3]); w.z = pk_bf16(v[4], v[5]); w.w = pk_bf16(v[6], v[7]);
                    if (u.pm < 256) *(u32x4*)(PX + (size_t)r * NIN + c0) = w;
                    else *(u32x4*)(PC + (size_t)(r - MROWS) * WR + c0) = w;
                }
                if (mode == 2) {
                    ss += __shfl_xor(ss, 16); ss += __shfl_xor(ss, 32);
                    if (fq == 0) VSS[(size_t)r * 16 + (pn - 14) * 4 + wc] = ss;
                }
            }
        return true;
    }
};

struct EpiMerge {
    static constexpr bool PERM = true;
    bf16_t* PX;
    struct Pre {}; __device__ __forceinline__ void prefetch(Pre&, const Unit&, int, int, int, int) const {}
    __device__ __forceinline__ bool operator()(f32x4 (&acc)[2][2][4][2], const Unit& u, int wr, int wc, int fr, int fq, const Pre& pre) const {
#pragma unroll
        for (int ai = 0; ai < 2; ++ai) {
            u32x4 gg[4][2], gr[4][2];
#pragma unroll
            for (int m = 0; m < 4; ++m)
#pragma unroll
                for (int bj = 0; bj < 2; ++bj) {
                    const int r = u.pm * 256 + ai * 128 + wr * 64 + m * 16 + fr, c0 = u.pn * 256 + bj * 128 + wc * 32 + fq * 8;
                    gg[m][bj] = *(const u32x4*)(PX + (size_t)r * NIN + OFF_GG + c0);
                    if (u.tag == 0) gr[m][bj] = *(const u32x4*)(PX + (size_t)r * NIN + OFF_GR + c0);
                }
#pragma unroll
            for (int m = 0; m < 4; ++m)
#pragma unroll
                for (int bj = 0; bj < 2; ++bj) {
                    const int r = u.pm * 256 + ai * 128 + wr * 64 + m * 16 + fr, c0 = u.pn * 256 + bj * 128 + wc * 32 + fq * 8;
                    const u32x4 ggv = gg[m][bj];
                    const float zg[8] = {bf_lo(ggv.x), bf_hi(ggv.x), bf_lo(ggv.y), bf_hi(ggv.y), bf_lo(ggv.z), bf_hi(ggv.z), bf_lo(ggv.w), bf_hi(ggv.w)};
                    float dg[8];
#pragma unroll
                    for (int k = 0; k < 8; ++k) dg[k] = 1.0f + __builtin_amdgcn_exp2f(fmaxf(zg[k], -60.0f) * -1.4426950408889634f);
                    if (u.tag == 0) {
                        const u32x4 grv = gr[m][bj];
                        const float zr[8] = {bf_lo(grv.x), bf_hi(grv.x), bf_lo(grv.y), bf_hi(grv.y), bf_lo(grv.z), bf_hi(grv.z), bf_lo(grv.w), bf_hi(grv.w)};
#pragma unroll
                        for (int n = 0; n < 2; ++n)
#pragma unroll
                            for (int j = 0; j < 4; ++j) acc[ai][bj][m][n][j] *= dg[n * 4 + j] * __builtin_amdgcn_rcpf(1.0f + __builtin_amdgcn_exp2f(zr[n * 4 + j] * -1.4426950408889634f));
                    } else {
                        float v[8];
#pragma unroll
                        for (int n = 0; n < 2; ++n)
#pragma unroll
                            for (int j = 0; j < 4; ++j) v[n * 4 + j] = acc[ai][bj][m][n][j] * __builtin_amdgcn_rcpf(dg[n * 4 + j]);
                        u32x4 w; w.x = pk_bf16(v[0], v[1]); w.y = pk_bf16(v[2], v[3]); w.z = pk_bf16(v[4], v[5]); w.w = pk_bf16(v[6], v[7]);
                        *(u32x4*)(PX + (size_t)r * NIN + c0) = w;
                    }
                }
        }
        return u.tag != 0;
    }
};

template <bool RES_BF16> struct EpiRes {
    static constexpr bool PERM = true;
    const void* res; bf16_t* out; const float* gate;
    struct Pre {}; __device__ __forceinline__ void prefetch(Pre&, const Unit&, int, int, int, int) const {}
    __device__ __forceinline__ bool operator()(f32x4 (&acc)[2][2][4][2], const Unit& u, int wr, int wc, int fr, int fq, const Pre& pre) const {
        const int b = u.pm >> 5;
        f32x4 gv[2][2];
#pragma unroll
        for (int bj = 0; bj < 2; ++bj)
#pragma unroll
            for (int n = 0; n < 2; ++n) gv[bj][n] = *(const f32x4*)(gate + (size_t)b * 6144 + u.pn * 256 + bj * 128 + wc * 32 + fq * 8 + n * 4);
        u32x4 rball[2][4][2];
        if (RES_BF16) {
#pragma unroll
            for (int ai = 0; ai < 2; ++ai)
#pragma unroll
                for (int m = 0; m < 4; ++m)
#pragma unroll
                    for (int bj = 0; bj < 2; ++bj)
                        rball[ai][m][bj] = *(const u32x4*)((const bf16_t*)res + (size_t)(u.pm * 256 + ai * 128 + wr * 64 + m * 16 + fr) * DM + u.pn * 256 + bj * 128 + wc * 32 + fq * 8);
        }
#pragma unroll
        for (int ai = 0; ai < 2; ++ai) {
            u32x4 rb[4][2]; f32x4 rf[4][2][2];
#pragma unroll
            for (int m = 0; m < 4; ++m)
#pragma unroll
                for (int bj = 0; bj < 2; ++bj) {
                    const size_t o = (size_t)(u.pm * 256 + ai * 128 + wr * 64 + m * 16 + fr) * DM + u.pn * 256 + bj * 128 + wc * 32 + fq * 8;
                    if (RES_BF16) rb[m][bj] = rball[ai][m][bj];
                    else { rf[m][bj][0] = *(const f32x4*)((const float*)res + o); rf[m][bj][1] = *(const f32x4*)((const float*)res + o + 4); }
                }
#pragma unroll
            for (int m = 0; m < 4; ++m)
#pragma unroll
                for (int bj = 0; bj < 2; ++bj) {
                    const size_t o = (size_t)(u.pm * 256 + ai * 128 + wr * 64 + m * 16 + fr) * DM + u.pn * 256 + bj * 128 + wc * 32 + fq * 8;
                    f32x4 x0, x1;
                    if (RES_BF16) { const u32x4 xr = rb[m][bj];
                        x0 = (f32x4){bf_lo(xr.x), bf_hi(xr.x), bf_lo(xr.y), bf_hi(xr.y)}; x1 = (f32x4){bf_lo(xr.z), bf_hi(xr.z), bf_lo(xr.w), bf_hi(xr.w)}; }
                    else { x0 = rf[m][bj][0]; x1 = rf[m][bj][1]; }
                    const f32x4 y0 = x0 + gv[bj][0] * acc[ai][bj][m][0], y1 = x1 + gv[bj][1] * acc[ai][bj][m][1];
                    u32x4 w; w.x = pk_bf16(y0.x, y0.y); w.y = pk_bf16(y0.z, y0.w); w.z = pk_bf16(y1.x, y1.y); w.w = pk_bf16(y1.z, y1.w);
                    *(u32x4*)(out + o) = w;
                }
        }
        return true;
    }
};

struct EpiUp {
    static constexpr bool PERM = true;
    bf16_t* UG; bf16_t* UV;
    struct Pre {}; __device__ __forceinline__ void prefetch(Pre&, const Unit&, int, int, int, int) const {}
    __device__ __forceinline__ bool operator()(f32x4 (&acc)[2][2][4][2], const Unit& u, int wr, int wc, int fr, int fq, const Pre& pre) const {
        bf16_t* base = u.pn < 11 ? UG : UV; const int pn = u.pn < 11 ? u.pn : u.pn - 11;
#pragma unroll
        for (int ai = 0; ai < 2; ++ai)
#pragma unroll
            for (int m = 0; m < 4; ++m) {
                const int r = u.pm * 256 + ai * 128 + wr * 64 + m * 16 + fr;
#pragma unroll
                for (int bj = 0; bj < 2; ++bj) {
                    const int c0 = pn * 256 + bj * 128 + wc * 32 + fq * 8;
                    u32x4 w; w.x = pk_bf16(acc[ai][bj][m][0][0], acc[ai][bj][m][0][1]); w.y = pk_bf16(acc[ai][bj][m][0][2], acc[ai][bj][m][0][3]);
                    w.z = pk_bf16(acc[ai][bj][m][1][0], acc[ai][bj][m][1][1]); w.w = pk_bf16(acc[ai][bj][m][1][2], acc[ai][bj][m][1][3]);
                    __builtin_nontemporal_store(w, (u32x4*)(base + (size_t)r * DFF + c0));
                }
            }
        return true;
    }
};

struct EpiGate {
    static constexpr bool PERM = false;
    const bf16_t* XR; const float* ba; const float* bx; const float* lam;
    float2* AGG; bf16_t* PX; bf16_t* G3A; bf16_t* G3B;
    struct Pre { u32x2 x[2][4]; };
    __device__ __forceinline__ void prefetch(Pre& pre, const Unit& u, int wr, int wc, int fr, int fq) const {
        const int ch = u.pn * 64 + wc * 16 + fq * 4;
#pragma unroll
        for (int ai = 0; ai < 2; ++ai)
#pragma unroll
            for (int m = 0; m < 4; ++m) pre.x[ai][m] = *(const u32x2*)(XR + (size_t)(u.pm * 256 + ai * 128 + wr * 64 + m * 16 + fr) * WR + ch);
    }
    __device__ __forceinline__ bool operator()(f32x4 (&acc)[2][2][4][2], const Unit& u, int wr, int wc, int fr, int fq, const Pre& pre) const {
        const int lane = fq * 16 + fr;
        const int ch = u.pn * 64 + wc * 16 + fq * 4;
        const bool isctx = u.pm >= 256;
        const int b = isctx ? (u.pm - 256) : (u.pm >> 5);
        f32x4 tb[2][3];
#pragma unroll
        for (int bj = 0; bj < 2; ++bj) { tb[bj][0] = *(const f32x4*)(ba + bj * WR + ch); tb[bj][1] = *(const f32x4*)(bx + bj * WR + ch); tb[bj][2] = *(const f32x4*)(lam + bj * WR + ch); }
        u32x2 rgv[2][4];
        if (!isctx) {
#pragma unroll
            for (int ai = 0; ai < 2; ++ai)
#pragma unroll
                for (int m = 0; m < 4; ++m) rgv[ai][m] = *(const u32x2*)(PX + (size_t)(u.pm * 256 + ai * 128 + wr * 64 + m * 16 + fr) * NIN + OFF_RG + ch);
        }
#pragma unroll
        for (int ai = 0; ai < 2; ++ai) {
            const int row0 = u.pm * 256 + ai * 128 + wr * 64;
            const int cidx = isctx ? (ai * 2 + wr) : (4 + (u.pm & 31) * 4 + ai * 2 + wr);
            u32x2 xrv[4];
#pragma unroll
            for (int m = 0; m < 4; ++m) xrv[m] = pre.x[ai][m];
#pragma unroll
            for (int bj = 0; bj < 2; ++bj) {
                const f32x4 bav = tb[bj][0], bxv = tb[bj][1], sp = tb[bj][2];
#pragma unroll
                for (int m = 0; m < 4; ++m) {
                    float av[4], bv[4];
                    const f32x4 xv4 = {bf_lo(xrv[m].x), bf_hi(xrv[m].x), bf_lo(xrv[m].y), bf_hi(xrv[m].y)};
#pragma unroll
                    for (int jp = 0; jp < 2; ++jp) {
                        const f32x2 z0 = {acc[ai][bj][m][0][2 * jp], acc[ai][bj][m][0][2 * jp + 1]}, z1 = {acc[ai][bj][m][1][2 * jp], acc[ai][bj][m][1][2 * jp + 1]};
                        const f32x2 ba2 = {bav[2 * jp], bav[2 * jp + 1]}, bx2 = {bxv[2 * jp], bxv[2 * jp + 1]}, sp2 = {sp[2 * jp], sp[2 * jp + 1]}, xv2 = {xv4[2 * jp], xv4[2 * jp + 1]};
                        const f32x2 u0 = z0 * (-1.4426950408889634f) + ba2, u1 = z1 * (-1.4426950408889634f) + bx2;
                        f32x2 e0, e1; e0.x = __builtin_amdgcn_exp2f(u0.x); e0.y = __builtin_amdgcn_exp2f(u0.y); e1.x = __builtin_amdgcn_exp2f(u1.x); e1.y = __builtin_amdgcn_exp2f(u1.y);
                        const f32x2 d0 = e0 + 1.0f, d1 = e1 + 1.0f;
                        f32x2 rg, ig; rg.x = __builtin_amdgcn_rcpf(d0.x); rg.y = __builtin_amdgcn_rcpf(d0.y); ig.x = __builtin_amdgcn_rcpf(d1.x); ig.y = __builtin_amdgcn_rcpf(d1.y);
                        const f32x2 la = sp2 * rg;
                        f32x2 a; a.x = __builtin_amdgcn_exp2f(la.x); a.y = __builtin_amdgcn_exp2f(la.y);
                        const f32x2 om = 1.0f - a * a;
                        f32x2 mult; mult.x = __builtin_amdgcn_sqrtf(om.x); mult.y = __builtin_amdgcn_sqrtf(om.y);
                        const f32x2 bb = mult * (ig * xv2);
                        av[2 * jp] = a.x; av[2 * jp + 1] = a.y; bv[2 * jp] = bb.x; bv[2 * jp + 1] = bb.y;
                    }
                    if (bj == 0) row_scan4_fwd(av[0], av[1], av[2], av[3], bv[0], bv[1], bv[2], bv[3]);
                    else row_scan4_bwd(av[0], av[1], av[2], av[3], bv[0], bv[1], bv[2], bv[3]);
#pragma unroll
                    for (int j = 0; j < 4; ++j) { acc[ai][bj][m][0][j] = av[j]; acc[ai][bj][m][1][j] = bv[j]; }
                }
                float hin[4] = {0.f, 0.f, 0.f, 0.f}, pin[4] = {1.f, 1.f, 1.f, 1.f};
                const int srcl = (lane & 48) | (bj == 0 ? 15 : 0);
#pragma unroll
                for (int mm = 0; mm < 4; ++mm) { const int m = (bj == 0) ? mm : 3 - mm;
#pragma unroll
                    for (int j = 0; j < 4; ++j) {
                        const float h = __builtin_fmaf(acc[ai][bj][m][0][j], hin[j], acc[ai][bj][m][1][j]);
                        const float P = acc[ai][bj][m][0][j] * pin[j];
                        acc[ai][bj][m][1][j] = h; acc[ai][bj][m][0][j] = P;
                        hin[j] = __shfl(h, srcl); pin[j] = __shfl(P, srcl);
                    } }
                if (fr == (bj == 0 ? 15 : 0)) {
                    float2* dst = AGG + ((size_t)(b * 2 + bj) * NCH + cidx) * WR + ch;
                    *(f32x4*)(dst) = (f32x4){pin[0], hin[0], pin[1], hin[1]};
                    *(f32x4*)(dst + 2) = (f32x4){pin[2], hin[2], pin[3], hin[3]};
                }
            }
            if (!isctx) {
                const bool odd = (fq & 1) != 0;
                const int chp = ch & ~7;
#pragma unroll
                for (int k = 0; k < 2; ++k) {
                    u32x2 w1[2], w2[2], w3[2];
#pragma unroll
                    for (int e = 0; e < 2; ++e) {
                        const int m = 2 * k + e;
                        const u32x2 gv = rgv[ai][m];
                        const float g0 = bf_lo(gv.x), g1 = bf_hi(gv.x), g2 = bf_lo(gv.y), g3 = bf_hi(gv.y);
                        w1[e].x = pk_bf16(g0 * (acc[ai][0][m][1][0] + acc[ai][1][m][1][0]), g1 * (acc[ai][0][m][1][1] + acc[ai][1][m][1][1]));
                        w1[e].y = pk_bf16(g2 * (acc[ai][0][m][1][2] + acc[ai][1][m][1][2]), g3 * (acc[ai][0][m][1][3] + acc[ai][1][m][1][3]));
                        w2[e].x = pk_bf16(g0 * acc[ai][0][m][0][0], g1 * acc[ai][0][m][0][1]); w2[e].y = pk_bf16(g2 * acc[ai][0][m][0][2], g3 * acc[ai][0][m][0][3]);
                        w3[e].x = pk_bf16(g0 * acc[ai][1][m][0][0], g1 * acc[ai][1][m][0][1]); w3[e].y = pk_bf16(g2 * acc[ai][1][m][0][2], g3 * acc[ai][1][m][0][3]);
                    }
                    const int row = row0 + (2 * k + (odd ? 1 : 0)) * 16 + fr;
                    const u32x2 s1 = odd ? w1[0] : w1[1], s2 = odd ? w2[0] : w2[1], s3 = odd ? w3[0] : w3[1];
                    const u32x2 k1 = odd ? w1[1] : w1[0], k2 = odd ? w2[1] : w2[0], k3 = odd ? w3[1] : w3[0];
                    u32x2 r1, r2, r3;
                    r1.x = __shfl_xor(s1.x, 16); r1.y = __shfl_xor(s1.y, 16); r2.x = __shfl_xor(s2.x, 16); r2.y = __shfl_xor(s2.y, 16); r3.x = __shfl_xor(s3.x, 16); r3.y = __shfl_xor(s3.y, 16);
                    const u32x4 o1 = odd ? (u32x4){r1.x, r1.y, k1.x, k1.y} : (u32x4){k1.x, k1.y, r1.x, r1.y};
                    const u32x4 o2 = odd ? (u32x4){r2.x, r2.y, k2.x, k2.y} : (u32x4){k2.x, k2.y, r2.x, r2.y};
                    const u32x4 o3 = odd ? (u32x4){r3.x, r3.y, k3.x, k3.y} : (u32x4){k3.x, k3.y, r3.x, r3.y};
                    *(u32x4*)(PX + (size_t)row * NIN + OFF_RG + chp) = o1;
                    *(u32x4*)(PX + (size_t)row * NIN + chp) = o2;
                    *(u32x4*)((row < 32768 ? G3A + (size_t)row * WR : G3B + (size_t)(row - 32768) * WR) + chp) = o3;
                }
            }
        }
        return true;
    }
};

__device__ __forceinline__ void transpose_tile(const float* __restrict__ src, int N, bf16_t* __restrict__ dst, int ldd, int koff, int kt, int nt, float* tile) {
    const int tid = threadIdx.x, k0 = kt * 64, n0 = nt * 64;
#pragma unroll
    for (int pass = 0; pass < 2; ++pass) {
        const int r = pass * 32 + (tid >> 4), c4 = (tid & 15) * 4;
        const f32x4 v = *(const f32x4*)(src + (size_t)(k0 + r) * N + n0 + c4);
        tile[r * 65 + c4 + 0] = v.x; tile[r * 65 + c4 + 1] = v.y; tile[r * 65 + c4 + 2] = v.z; tile[r * 65 + c4 + 3] = v.w;
    }
    __syncthreads();
    {
        const int n = tid >> 3, k8 = (tid & 7) * 8;
        float v[8];
#pragma unroll
        for (int i = 0; i < 8; ++i) v[i] = tile[(k8 + i) * 65 + n];
        u32x4 w; w.x = pk_bf16(v[0], v[1]); w.y = pk_bf16(v[2], v[3]); w.z = pk_bf16(v[4], v[5]); w.w = pk_bf16(v[6], v[7]);
        *(u32x4*)(dst + (size_t)(n0 + n) * ldd + koff + k0 + k8) = w;
    }
    __syncthreads();
}

__device__ __forceinline__ void phase_prep(const Params& p_unused, unsigned char* smem) {
    const Params p = load_params();
    unsigned char* ws = p.ws;
    float* tile = (float*)smem;
    const int tid = threadIdx.x, G = gridDim.x;
    for (int task = blockIdx.x; task < 4608; task += G) {
        int t = task;
        if (t < 1664) { transpose_tile(p.in[7], NIN, (bf16_t*)(ws + WS_WIN), 1024, 0, t / 104, t % 104, tile); continue; } t -= 1664;
        if (t < 320) { transpose_tile(p.in[18], 1024, (bf16_t*)(ws + WS_WPRG), 2304, 0, t / 16, t % 16, tile); continue; } t -= 320;
        if (t < 256) { transpose_tile(p.in[19], 1024, (bf16_t*)(ws + WS_WPRG), 2304, 1280, t / 16, t % 16, tile); continue; } t -= 256;
        if (t < 256) { transpose_tile(p.in[20], 1024, (bf16_t*)(ws + WS_WOUT), 1024, 0, t / 16, t % 16, tile); continue; } t -= 256;
        if (t < 1408) { transpose_tile(p.in[22], 5632, (bf16_t*)(ws + WS_WUP), 1024, 0, t / 88, t % 88, tile); continue; } t -= 1408;
        transpose_tile(p.in[25], 1024, (bf16_t*)(ws + WS_WDN), 2816, 0, t / 16, t % 16, tile);
    }
    {
        bf16_t* WG = (bf16_t*)(ws + WS_WG);
        const float* wa = p.in[11]; const float* wx = p.in[13];
        for (int e = blockIdx.x * 512 + tid; e < 20 * 256 * 256; e += G * 512) {
            const int jj0 = e & 63, k = (e >> 6) & 255, rest = e >> 14;
            const int gate = rest & 1, dir = (rest >> 1) & 1, pn = rest >> 2;
            const int head = pn >> 2, quarter = pn & 3;
            const float v = (gate ? wx : wa)[((size_t)(dir * 5 + head) * 256 + k) * 256 + quarter * 64 + jj0];
            const int wc = jj0 >> 4, fq = (jj0 >> 2) & 3, j = jj0 & 3;
            const int c = 128 * dir + 32 * wc + 16 * gate + 4 * fq + j;
            WG[((size_t)pn * 256 + c) * 256 + k] = (bf16_t)(pk_bf16(v, v) & 0xffffu);
        }
    }
    {
        bf16_t* WS_ = (bf16_t*)(ws + WS_WS); const float* w_s = p.in[16];
        for (int e = blockIdx.x * 512 + tid; e < 8 * 128 * 128 / 2; e += G * 512) ((unsigned*)WS_)[e] = pk_bf16(w_s[2 * e], w_s[2 * e + 1]);
    }
    {
        float* SPT = (float*)(ws + WS_SPT); const float* lam = p.in[10]; const float* ba = p.in[12]; const float* bx = p.in[14];
        for (int e = blockIdx.x * 512 + tid; e < 2 * WR; e += G * 512) {
            SPT[e] = -1.4426950408889634f * ba[e]; SPT[2 * WR + e] = -1.4426950408889634f * bx[e];
            SPT[4 * WR + e] = -8.0f * 1.4426950408889634f * log1pf(expf(-lam[e]));
        }
    }
    {
        const float* c = p.in[1]; const float* cctx = p.in[3]; const float* w_mod = p.in[4];
        float* MPART = (float*)(ws + WS_MPART);
        const int lane = tid & 63, wid = tid >> 6;
        for (int task = blockIdx.x * 8 + wid; task < 1536; task += G * 8) {
            const int cgp = task % 96, ks = task / 96, col = cgp * 64 + lane;
#define REP9(X) X(0) X(1) X(2) X(3) X(4) X(5) X(6) X(7) X(8)
#define GV_DECL(v) float sv##v, a9_##v = 0.f; { const float x = ((v) < 8) ? c[(v) * 1024 + ks * 64 + lane] : cctx[ks * 64 + lane]; sv##v = x / (1.0f + __expf(-x)); }
            REP9(GV_DECL)
#pragma unroll 8
            for (int kk = 0; kk < 64; ++kk) {
                const float w = w_mod[(size_t)(ks * 64 + kk) * 6144 + col];
#define GV_FMA(v) a9_##v += __int_as_float(__builtin_amdgcn_readlane(__float_as_int(sv##v), kk)) * w;
                REP9(GV_FMA)
            }
#define GV_ST(v) MPART[((size_t)ks * 9 + (v)) * 6144 + col] = a9_##v;
            REP9(GV_ST)
#undef GV_DECL
#undef GV_FMA
#undef GV_ST
        }
    }
}

template <bool SRC_BF16> __device__ __forceinline__ void row_load16(const void* srow, int lane, f32x4 (&a)[4]) {
    if (SRC_BF16) {
        const u32x4* s = (const u32x4*)srow;
        const u32x4 v0 = s[lane], v1 = s[64 + lane];
        a[0] = (f32x4){bf_lo(v0.x), bf_hi(v0.x), bf_lo(v0.y), bf_hi(v0.y)}; a[1] = (f32x4){bf_lo(v0.z), bf_hi(v0.z), bf_lo(v0.w), bf_hi(v0.w)};
        a[2] = (f32x4){bf_lo(v1.x), bf_hi(v1.x), bf_lo(v1.y), bf_hi(v1.y)}; a[3] = (f32x4){bf_lo(v1.z), bf_hi(v1.z), bf_lo(v1.w), bf_hi(v1.w)};
    } else {
        const f32x4* s = (const f32x4*)srow;
        a[0] = s[lane * 2]; a[1] = s[lane * 2 + 1]; a[2] = s[128 + lane * 2]; a[3] = s[128 + lane * 2 + 1];
    }
}
__device__ __forceinline__ float row_rstd(const f32x4 (&a)[4]) {
    float ss = 0.f;
#pragma unroll
    for (int i = 0; i < 4; ++i) ss += a[i].x * a[i].x + a[i].y * a[i].y + a[i].z * a[i].z + a[i].w * a[i].w;
#pragma unroll
    for (int o = 32; o > 0; o >>= 1) ss += __shfl_xor(ss, o);
    return rsqrtf(ss * (1.0f / 1024.0f) + 1e-6f);
}
template <bool SRC_BF16> __device__ __forceinline__ void row_norm_mod(const void* srow, bf16_t* __restrict__ drow, const float* gs, const float* sh, int lane) {
    f32x4 a[4]; row_load16<SRC_BF16>(srow, lane, a);
    const float rstd = row_rstd(a);
#pragma unroll
    for (int hlf = 0; hlf < 2; ++hlf) {
        const int c0 = hlf * 512 + lane * 8;
        const f32x4 g0 = *(const f32x4*)(gs + c0), g1 = *(const f32x4*)(gs + c0 + 4), h0 = *(const f32x4*)(sh + c0), h1 = *(const f32x4*)(sh + c0 + 4);
        const f32x4 y0 = a[hlf * 2] * rstd * g0 + h0, y1 = a[hlf * 2 + 1] * rstd * g1 + h1;
        u32x4 w; w.x = pk_bf16(y0.x, y0.y); w.y = pk_bf16(y0.z, y0.w); w.z = pk_bf16(y1.x, y1.y); w.w = pk_bf16(y1.z, y1.w);
        *(u32x4*)(drow + c0) = w;
    }
}

template <bool FIRST> __device__ __forceinline__ void phase_norm(const Params& p_unused, unsigned char* smem) {
    const Params p = load_params();
    unsigned char* ws = p.ws;
    const int tid = threadIdx.x, lane = tid & 63, wid = tid >> 6, G = gridDim.x;
    float* gs = (float*)smem; float* sh = gs + 1024; float* gsc = sh + 1024; float* shc = gsc + 1024;
    const float* MPART = (const float*)(ws + WS_MPART); float* MFIN = (float*)(ws + WS_MFIN);
    const float* b_mod = p.in[5];
    const float* gn = FIRST ? p.in[6] : p.in[21];
    if (FIRST) {
        for (int e = blockIdx.x * 512 + tid; e < 9 * 6144; e += G * 512) {
            const int v = e / 6144, col = e % 6144; float s = b_mod[col];
#pragma unroll
            for (int ks = 0; ks < 16; ++ks) s += MPART[((size_t)ks * 9 + v) * 6144 + col];
            MFIN[e] = s;
        }
    }
    for (int grp = blockIdx.x; grp < 256; grp += G) {
        const int b = grp >> 5;
        __syncthreads();
        for (int e = tid; e < 2048; e += 512) {
            const int col = (FIRST ? 0 : 3 * 1024) + e;
            float s, sc = 0.f;
            if (FIRST) { s = b_mod[col]; sc = b_mod[col];
#pragma unroll
                for (int ks = 0; ks < 16; ++ks) { s += MPART[((size_t)ks * 9 + b) * 6144 + col]; sc += MPART[((size_t)ks * 9 + 8) * 6144 + col]; } }
            else s = MFIN[(size_t)b * 6144 + col];
            if (e < 1024) { sh[e] = s; if (FIRST) shc[e] = sc; }
            else { gs[e - 1024] = gn[e - 1024] * (1.0f + s); if (FIRST) gsc[e - 1024] = gn[e - 1024] * (1.0f + sc); }
        }
        __syncthreads();
        bf16_t* dst = FIRST ? (bf16_t*)p.out : (bf16_t*)(ws + WS_H2);
        for (int i = 0; i < 32; ++i) { const size_t row = (size_t)grp * 256 + wid * 32 + i;
            if (FIRST) row_norm_mod<false>(p.in[0] + row * DM, dst + row * DM, gs, sh, lane);
            else row_norm_mod<true>((const bf16_t*)p.out + row * DM, dst + row * DM, gs, sh, lane); }
        if (FIRST) { const size_t crow = (size_t)grp * 8 + wid; row_norm_mod<false>(p.in[2] + crow * DM, (bf16_t*)p.out + ((size_t)MROWS + crow) * DM, gsc, shc, lane); }
    }
}

__device__ __forceinline__ void phase_conv1d(const Params& p_unused) {
    const Params p = load_params();
    unsigned char* ws = p.ws;
    const bf16_t* PX = (const bf16_t*)(ws + WS_PX); const bf16_t* PC = (const bf16_t*)(ws + WS_PC);
    bf16_t* XR = (bf16_t*)p.out;
    const float* cw = p.in[8]; const float* cb = p.in[9];
    const int lane = threadIdx.x & 63, gw = blockIdx.x * 8 + (threadIdx.x >> 6), nw = gridDim.x * 8;
    const int nslot = nw / 5;
    if (gw >= nslot * 5) return;
    const int gb = gw % 5, slot = gw / 5, ch = gb * 256 + lane * 4;
    const int total = MROWS + MCTX, per = (total + nslot - 1) / nslot;
    const int r0 = slot * per, r1 = (r0 + per < total) ? r0 + per : total;
    const f32x4 w0 = *(const f32x4*)(cw + 0 * WR + ch), w1 = *(const f32x4*)(cw + 1 * WR + ch), w2 = *(const f32x4*)(cw + 2 * WR + ch), w3 = *(const f32x4*)(cw + 3 * WR + ch);
    const f32x4 bias = *(const f32x4*)(cb + ch);
#pragma unroll 4
    for (int row = r0; row < r1; ++row) {
        const bf16_t* src; int ld, t, T;
        if (row < MROWS) { t = row & (SEQ - 1); T = SEQ; src = PX + (size_t)row * NIN + ch; ld = NIN; }
        else { const int r2 = row - MROWS; t = r2 & (CTXL - 1); T = CTXL; src = PC + (size_t)r2 * WR + ch; ld = WR; }
        const u32x2 z = {0u, 0u};
        const u32x2 v0 = (t >= 2) ? *(const u32x2*)(src - 2 * (long)ld) : z;
        const u32x2 v1 = (t >= 1) ? *(const u32x2*)(src - (long)ld) : z;
        const u32x2 v2 = *(const u32x2*)(src);
        const u32x2 v3 = (t + 1 < T) ? *(const u32x2*)(src + ld) : z;
        f32x4 a = bias;
        a += w0 * (f32x4){bf_lo(v0.x), bf_hi(v0.x), bf_lo(v0.y), bf_hi(v0.y)};
        a += w1 * (f32x4){bf_lo(v1.x), bf_hi(v1.x), bf_lo(v1.y), bf_hi(v1.y)};
        a += w2 * (f32x4){bf_lo(v2.x), bf_hi(v2.x), bf_lo(v2.y), bf_hi(v2.y)};
        a += w3 * (f32x4){bf_lo(v3.x), bf_hi(v3.x), bf_lo(v3.y), bf_hi(v3.y)};
        u32x2 w; w.x = pk_bf16(a.x, a.y); w.y = pk_bf16(a.z, a.w);
        *(u32x2*)(XR + (size_t)row * WR + ch) = w;
    }
}

__device__ __forceinline__ void phase_chunk_mlp(const Params& p_unused, unsigned char* smem) {
    const Params p = load_params();
    unsigned char* ws = p.ws;
    bf16_t* PX = (bf16_t*)(ws + WS_PX);
    const bf16_t* WSb = (const bf16_t*)(ws + WS_WS); const float* VSS = (const float*)(ws + WS_VSS);
    const float* g_v = p.in[15]; const float* b_s = p.in[17];
    constexpr int LDT = 136;
    bf16_t* Wl = (bf16_t*)smem; bf16_t* Vt = Wl + 128 * LDT; float* rs = (float*)(Vt + 128 * LDT);
    const int tid = threadIdx.x, lane = tid & 63, wid = tid >> 6, fr = lane & 15, fq = lane >> 4;
    int cur_h = -1;
    const int p0 = (wid >> 1) * 32, c0 = (wid & 1) * 64;
    for (int task = blockIdx.x; task < NB * 64 * 8; task += gridDim.x) {
        const int h = task & 7, n = (task >> 3) & 63, b = task >> 9;
        const size_t row0 = (size_t)b * SEQ + (size_t)n * 128;
        __syncthreads();
        if (tid < 128) { const f32x4* q = (const f32x4*)(VSS + (row0 + tid) * 16); const f32x4 s = q[0] + q[1] + q[2] + q[3]; rs[tid] = rsqrtf((s.x + s.y + s.z + s.w) * (1.0f / 1024.0f) + 1e-6f); }
        if (h != cur_h) {
            cur_h = h;
#pragma unroll
            for (int i = 0; i < 4; ++i) { const int e = tid + i * 512, r = e >> 4, c8 = (e & 15) * 8;
                *(u32x4*)(Wl + r * LDT + c8) = *(const u32x4*)(WSb + (size_t)h * 16384 + r * 128 + c8); }
        }
        u32x4 vraw[4];
#pragma unroll
        for (int i = 0; i < 4; ++i) { const int e = tid + i * 512, q = e >> 4, c8 = (e & 15) * 8; vraw[i] = *(const u32x4*)(PX + (row0 + q) * NIN + OFF_V + h * 128 + c8); }
        u32x2 uraw[2][4];
#pragma unroll
        for (int mi = 0; mi < 2; ++mi)
#pragma unroll
            for (int ni = 0; ni < 4; ++ni) uraw[mi][ni] = *(const u32x2*)(PX + (row0 + p0 + mi * 16 + fr) * NIN + OFF_U + h * 128 + c0 + ni * 16 + fq * 4);
        __syncthreads();
#pragma unroll
        for (int i = 0; i < 4; ++i) { const int e = tid + i * 512, q = e >> 4, c8 = (e & 15) * 8;
            const u32x4 v = vraw[i];
            const float r = rs[q];
            const f32x4 g0 = *(const f32x4*)(g_v + h * 128 + c8), g1 = *(const f32x4*)(g_v + h * 128 + c8 + 4);
            const float f[8] = {bf_lo(v.x) * r * g0.x, bf_hi(v.x) * r * g0.y, bf_lo(v.y) * r * g0.z, bf_hi(v.y) * r * g0.w,
                                bf_lo(v.z) * r * g1.x, bf_hi(v.z) * r * g1.y, bf_lo(v.w) * r * g1.z, bf_hi(v.w) * r * g1.w};
#pragma unroll
            for (int k = 0; k < 8; k += 2) { const unsigned w = pk_bf16(f[k], f[k + 1]); Vt[(c8 + k) * LDT + q] = (bf16_t)(w & 0xffffu); Vt[(c8 + k + 1) * LDT + q] = (bf16_t)(w >> 16); }
        }
        __syncthreads();
        f32x4 acc[2][4];
#pragma unroll
        for (int mi = 0; mi < 2; ++mi)
#pragma unroll
            for (int ni = 0; ni < 4; ++ni) acc[mi][ni] = (f32x4){0.f, 0.f, 0.f, 0.f};
#pragma unroll
        for (int kk = 0; kk < 4; ++kk) {
            bf16x8 af[2], bfv[4];
#pragma unroll
            for (int mi = 0; mi < 2; ++mi) af[mi] = *(const bf16x8*)(Wl + (p0 + mi * 16 + fr) * LDT + kk * 32 + fq * 8);
#pragma unroll
            for (int ni = 0; ni < 4; ++ni) bfv[ni] = *(const bf16x8*)(Vt + (c0 + ni * 16 + fr) * LDT + kk * 32 + fq * 8);
#pragma unroll
            for (int mi = 0; mi < 2; ++mi)
#pragma unroll
                for (int ni = 0; ni < 4; ++ni) acc[mi][ni] = __builtin_amdgcn_mfma_f32_16x16x32_bf16(bfv[ni], af[mi], acc[mi][ni], 0, 0, 0);
        }
#pragma unroll
        for (int mi = 0; mi < 2; ++mi) {
            const int pp = p0 + mi * 16 + fr; const float bias = b_s[pp * 8 + h];
#pragma unroll
            for (int ni = 0; ni < 4; ++ni) {
                bf16_t* up = PX + (row0 + pp) * NIN + OFF_U + h * 128 + c0 + ni * 16 + fq * 4;
                const u32x2 uv = uraw[mi][ni];
                const f32x2 u01 = gelu_pk2((f32x2){bf_lo(uv.x), bf_hi(uv.x)}), u23 = gelu_pk2((f32x2){bf_lo(uv.y), bf_hi(uv.y)});
                u32x2 w; w.x = pk_bf16(u01.x * (acc[mi][ni].x + bias), u01.y * (acc[mi][ni].y + bias));
                w.y = pk_bf16(u23.x * (acc[mi][ni].z + bias), u23.y * (acc[mi][ni].w + bias));
                *(u32x2*)up = w;
            }
        }
    }
}

__device__ __forceinline__ void phase_carry_fix(const Params& p_unused, unsigned char* smem) {
    const Params p = load_params();
    unsigned char* ws = p.ws;
    const float2* __restrict__ AGG = (const float2*)(ws + WS_AGG);
    bf16_t* PX = (bf16_t*)(ws + WS_PX);
    const bf16_t* G3A = (const bf16_t*)(ws + WS_G3A); const bf16_t* G3B = (const bf16_t*)((const unsigned char*)p.out + OUT_G3B);
    float* carr = (float*)smem;
    const int tid = threadIdx.x;
    for (int grp = blockIdx.x; grp < 256; grp += gridDim.x) {
        const int b = grp >> 5, q = grp & 31, c0 = 4 + 4 * q;
        __syncthreads();
#pragma unroll 1
        for (int k = 0; k < 5; ++k) {
            const int sidx = tid + k * 512, dir = sidx / WR, ch = sidx - dir * WR;
            const float2* ag = AGG + (size_t)(b * 2 + dir) * NCH * WR + ch;
            float* cr = carr + (size_t)dir * 4 * WR + ch;
            float h = 0.f;
            if (dir == 0) {
#pragma unroll 8
                for (int ci = 0; ci < c0; ++ci) { const float2 ab = ag[(size_t)ci * WR]; h = ab.x * h + ab.y; }
#pragma unroll
                for (int e = 0; e < 4; ++e) { const float2 ab = ag[(size_t)(c0 + e) * WR]; cr[e * WR] = h; h = ab.x * h + ab.y; }
            } else {
#pragma unroll
                for (int ci = 3; ci >= 0; --ci) { const float2 ab = ag[(size_t)ci * WR]; h = ab.x * h + ab.y; }
#pragma unroll 8
                for (int ci = NCH - 1; ci > c0 + 3; --ci) { const float2 ab = ag[(size_t)ci * WR]; h = ab.x * h + ab.y; }
#pragma unroll
                for (int e = 3; e >= 0; --e) { const float2 ab = ag[(size_t)(c0 + e) * WR]; cr[e * WR] = h; h = ab.x * h + ab.y; }
            }
        }
        __syncthreads();
        const size_t row0 = (size_t)grp * 256;
#pragma unroll 2
        for (int it = tid; it < 256 * 160; it += 512) {
            const int r = it / 160, ch = (it - r * 160) * 8, e = r >> 6;
            const size_t row = row0 + r;
            bf16_t* p1 = PX + row * NIN + OFF_RG + ch;
            const u32x4 g1 = *(const u32x4*)p1;
            const u32x4 g2 = *(const u32x4*)(PX + row * NIN + ch);
            const u32x4 g3 = *(const u32x4*)((row < 32768 ? G3A + row * WR : G3B + (row - 32768) * WR) + ch);
            const f32x4 cf0 = *(const f32x4*)(carr + e * WR + ch), cf1 = *(const f32x4*)(carr + e * WR + ch + 4);
            const f32x4 cb0 = *(const f32x4*)(carr + (4 + e) * WR + ch), cb1 = *(const f32x4*)(carr + (4 + e) * WR + ch + 4);
            u32x4 w;
            w.x = pk_bf16(bf_lo(g1.x) + bf_lo(g2.x) * cf0.x + bf_lo(g3.x) * cb0.x, bf_hi(g1.x) + bf_hi(g2.x) * cf0.y + bf_hi(g3.x) * cb0.y);
            w.y = pk_bf16(bf_lo(g1.y) + bf_lo(g2.y) * cf0.z + bf_lo(g3.y) * cb0.z, bf_hi(g1.y) + bf_hi(g2.y) * cf0.w + bf_hi(g3.y) * cb0.w);
            w.z = pk_bf16(bf_lo(g1.z) + bf_lo(g2.z) * cf1.x + bf_lo(g3.z) * cb1.x, bf_hi(g1.z) + bf_hi(g2.z) * cf1.y + bf_hi(g3.z) * cb1.y);
            w.w = pk_bf16(bf_lo(g1.w) + bf_lo(g2.w) * cf1.z + bf_lo(g3.w) * cb1.z, bf_hi(g1.w) + bf_hi(g2.w) * cf1.w + bf_hi(g3.w) * cb1.w);
            *(u32x4*)p1 = w;
        }
    }
}

__device__ __forceinline__ void c2_load(u32x2 (&raw)[6], const bf16_t* base, int gi0, int jj) {
#pragma unroll
    for (int r = 0; r < 6; ++r) {
        const int ii = gi0 - 1 + r;
        const bool ok = (ii >= 0) && (ii < 128) && (jj >= 0) && (jj < 64);
        const u32x2 z = {0u, 0u};
        raw[r] = ok ? *(const u32x2*)(base + (size_t)(ii * 64 + jj) * DFF) : z;
    }
}
__device__ __forceinline__ void c2_unpack(f32x4 (&W)[6], const u32x2 (&raw)[6]) {
#pragma unroll
    for (int r = 0; r < 6; ++r) W[r] = (f32x4){bf_lo(raw[r].x), bf_hi(raw[r].x), bf_lo(raw[r].y), bf_hi(raw[r].y)};
}
__device__ __forceinline__ void c2_step(const f32x4 (&A)[6], const f32x4 (&B)[6], f32x4 (&C)[6], u32x2 (&raw)[6], const f32x4 (&w)[9], const f32x4 bias,
                                        const bf16_t* ugb, bf16_t* uvb, int gi0, int j) {
    c2_unpack(C, raw);
    c2_load(raw, ugb, gi0, j + 2);
#pragma unroll
    for (int r = 0; r < 4; ++r) {
        f32x4 a = bias;
#pragma unroll
        for (int di = 0; di < 3; ++di) a += w[di * 3 + 0] * A[r + di] + w[di * 3 + 1] * B[r + di] + w[di * 3 + 2] * C[r + di];
        bf16_t* up = uvb + (size_t)((gi0 + r) * 64 + j) * DFF;
        const u32x2 uv = *(const u32x2*)up;
        const f32x2 g0 = gelu_pk2((f32x2){a.x, a.y}), g1 = gelu_pk2((f32x2){a.z, a.w});
        u32x2 o; o.x = pk_bf16(g0.x * bf_lo(uv.x), g0.y * bf_hi(uv.x)); o.y = pk_bf16(g1.x * bf_lo(uv.y), g1.y * bf_hi(uv.y));
        *(u32x2*)up = o;
    }
}
__device__ __forceinline__ void phase_conv2d(const Params& p_unused) {
    const Params p = load_params();
    unsigned char* ws = p.ws;
    const bf16_t* UG = (const bf16_t*)(ws + WS_UG); bf16_t* UV = (bf16_t*)(ws + WS_UV);
    const float* cw = p.in[23]; const float* cb = p.in[24];
    const int lane = threadIdx.x & 63, gw = blockIdx.x * 8 + (threadIdx.x >> 6), nw = gridDim.x * 8;
    for (int task = gw; task < 11 * 8 * 32 * 2; task += nw) {
        const int gb = task % 11, rest = task / 11, half = rest & 1, band = (rest >> 1) & 31, b = rest >> 6;
        const int ch = gb * 256 + lane * 4, gi0 = band * 4, j0 = half * 32;
        f32x4 w[9];
#pragma unroll
        for (int k = 0; k < 9; ++k) w[k] = *(const f32x4*)(cw + k * DFF + ch);
        const f32x4 bias = *(const f32x4*)(cb + ch);
        const bf16_t* ugb = UG + (size_t)b * SEQ * DFF + ch; bf16_t* uvb = UV + (size_t)b * SEQ * DFF + ch;
        f32x4 W0[6], W1[6], W2[6]; u32x2 raw[6];
        c2_load(raw, ugb, gi0, j0 - 1); c2_unpack(W0, raw);
        c2_load(raw, ugb, gi0, j0); c2_unpack(W1, raw);
        c2_load(raw, ugb, gi0, j0 + 1);
        const int jend = j0 + 32;
#pragma unroll 1
        for (int j = j0; j < jend; j += 3) {
            c2_step(W0, W1, W2, raw, w, bias, ugb, uvb, gi0, j);
            if (j + 1 < jend) c2_step(W1, W2, W0, raw, w, bias, ugb, uvb, gi0, j + 1);
            if (j + 2 < jend) c2_step(W2, W0, W1, raw, w, bias, ugb, uvb, gi0, j + 2);
        }
    }
}

__device__ __forceinline__ void phase_final(const Params& p_unused) {
    const Params p = load_params();
    const float* gf = p.in[26];
    const bf16_t* X2 = (const bf16_t*)(p.ws + WS_H2);
    const int lane = threadIdx.x & 63, wid = threadIdx.x >> 6;
    f32x4 g[4] = {*(const f32x4*)(gf + lane * 8), *(const f32x4*)(gf + lane * 8 + 4), *(const f32x4*)(gf + 512 + lane * 8), *(const f32x4*)(gf + 512 + lane * 8 + 4)};
    for (int row = blockIdx.x * 8 + wid; row < MROWS; row += gridDim.x * 8) {
        f32x4 a[4]; row_load16<true>(X2 + (size_t)row * DM, lane, a);
        const float rstd = row_rstd(a);
        f32x4* d = (f32x4*)(p.out + (size_t)row * DM);
        __builtin_nontemporal_store(a[0] * rstd * g[0], d + lane * 2); __builtin_nontemporal_store(a[1] * rstd * g[1], d + lane * 2 + 1);
        __builtin_nontemporal_store(a[2] * rstd * g[2], d + 128 + lane * 2); __builtin_nontemporal_store(a[3] * rstd * g[3], d + 128 + lane * 2 + 1);
    }
}

#define XB_TMO      128
#define XB_XCNT(j)  (256  + 64 * (j))
#define XB_XSUB(j)  (1280 + 64 * (j))
#define XB_XGEN(j)  (2304 + 64 * (j))
#define XB_TOP      3328
#define XB_TOPGEN   3392
#define XCD_BAR_WORDS 3456
#define XB_SPIN_CAP (1u << 18)
__device__ __forceinline__ unsigned xb_ld(unsigned* p)              { return __hip_atomic_load(p, __ATOMIC_RELAXED, __HIP_MEMORY_SCOPE_AGENT); }
__device__ __forceinline__ unsigned xb_add(unsigned* p, unsigned v) { return __hip_atomic_fetch_add(p, v, __ATOMIC_RELAXED, __HIP_MEMORY_SCOPE_AGENT); }
__device__ __forceinline__ unsigned xb_xcc_id() { return (unsigned)__builtin_amdgcn_s_getreg((3 << 11) | 20) & 0xFu; }
#define XB_SPIN(cond, bar) do { unsigned _sp = 0; while (cond) { __builtin_amdgcn_s_sleep(1); \
    if ((++_sp & 255u) == 0u) { if (xb_ld(&(bar)[XB_TMO])) break; if (_sp > XB_SPIN_CAP) { atomicAdd(&(bar)[XB_TMO], 1u); break; } } } } while (0)
struct XcdBarrier { unsigned* bar; unsigned x; volatile LAS unsigned* st; };
__device__ __forceinline__ XcdBarrier xcd_barrier_post(unsigned* bar, volatile LAS unsigned* st) {
    XcdBarrier b; b.bar = bar; b.x = xb_xcc_id(); b.st = st;
    if (threadIdx.x == 0) (void)xb_add(&bar[XB_XCNT(b.x)], 1u);
    return b;
}
__device__ __forceinline__ void xcd_barrier_complete(unsigned* bar, unsigned x, unsigned& nloc, unsigned& nx) {
    const unsigned G = gridDim.x * gridDim.y * gridDim.z;
    unsigned sum, cnt, mine, sp = 0u;
    for (;;) {
        sum = 0u; cnt = 0u; mine = 0u;
#pragma unroll
        for (unsigned j = 0; j < 16; ++j) { const unsigned c = xb_ld(&bar[XB_XCNT(j)]); sum += c; cnt += (c > 0u) ? 1u : 0u; mine = (j == x) ? c : mine; }
        if (sum == G) break;
        __builtin_amdgcn_s_sleep(1);
        if ((++sp & 255u) == 0u) { if (xb_ld(&bar[XB_TMO])) break; if (sp > XB_SPIN_CAP) { atomicAdd(&bar[XB_TMO], 1u); break; } }
    }
    nloc = mine > 0u ? mine : 1u; nx = cnt > 0u ? cnt : 1u;
}
__device__ __forceinline__ void xcd_barrier(const XcdBarrier& b) {
    asm volatile("s_waitcnt vmcnt(0)" ::: "memory");
    __syncthreads();
    if (threadIdx.x == 0) {
        unsigned* bar = b.bar;
        __builtin_amdgcn_s_waitcnt(0);
        unsigned nloc = b.st[0], nx = b.st[1];
        if (nloc == 0u) { xcd_barrier_complete(bar, b.x, nloc, nx); b.st[0] = nloc; b.st[1] = nx; }
        const unsigned old = xb_add(&bar[XB_XSUB(b.x)], 1u);
        const unsigned gen = old / nloc;
        if (old + 1u == (gen + 1u) * nloc) {
            __builtin_amdgcn_fence(__ATOMIC_RELEASE, "agent");
            asm volatile("s_waitcnt vmcnt(0)" ::: "memory");
            const unsigned og = xb_add(&bar[XB_TOP], 1u);
            const unsigned tg = og / nx;
            if (og + 1u == (tg + 1u) * nx) xb_add(&bar[XB_TOPGEN], 1u);
            else XB_SPIN(xb_ld(&bar[XB_TOPGEN]) == tg, bar);
            __builtin_amdgcn_fence(__ATOMIC_ACQUIRE, "agent");
            xb_add(&bar[XB_XGEN(b.x)], 1u);
            asm volatile("s_waitcnt vmcnt(0)" ::: "memory");
        } else {
            XB_SPIN(xb_ld(&bar[XB_XGEN(b.x)]) == gen, bar);
            __builtin_amdgcn_fence(__ATOMIC_ACQUIRE, "agent");
            asm volatile("s_waitcnt vmcnt(0)" ::: "memory");
        }
    }
    __syncthreads();
}

__global__ void __launch_bounds__(512, 2) mega(Params p) {
    extern __shared__ __attribute__((aligned(16))) unsigned char smem[];
    LAS unsigned char* lds = (LAS unsigned char*)smem;
    const int G = gridDim.x, c = blockIdx.x;
#ifndef PH_MASK
#define PH_MASK 0x3fff
#endif
#define IN(k) (((PH_MASK >> (k)) & 1) && p.ph_lo <= (k) && (k) < p.ph_hi)
#ifndef REP_MASK
#define REP_MASK 0
#endif
#define REPS(k) _Pragma("unroll 1") for (int rep_ = 0; rep_ < (((REP_MASK >> (k)) & 1) ? 2 : 1); ++rep_)
#define SEAM(k) do { if (IN(k) && IN((k) + 1)) { if ((k) == 0) cg::this_grid().sync(); else xcd_barrier(xb); } } while (0)
    volatile LAS unsigned* xst = (volatile LAS unsigned*)(lds + 131072);
    if (threadIdx.x < 4) xst[threadIdx.x] = 0u;
    __syncthreads();
    const XcdBarrier xb = xcd_barrier_post((unsigned*)(load_params().ws + WS_BAR), xst);

    if (IN(0)) REPS(0) phase_prep(p, smem);
    SEAM(0);
    if (IN(1)) REPS(1) phase_norm<true>(p, smem);
    SEAM(1);
    if (IN(2)) REPS(2) {
        __syncthreads();
        const Params q = load_params(); unsigned char* ws = q.ws; bf16_t* PX = (bf16_t*)(ws + WS_PX); float* MFIN = (float*)(ws + WS_MFIN); (void)PX; (void)MFIN;
        pg8::GemmD g{(const bf16_t*)q.out, (const bf16_t*)(ws + WS_WIN), DM, DM};
        SchedIn S{G, c}; EpiIn E{PX, (bf16_t*)(ws + WS_PC), (float*)(ws + WS_VSS)};
        pg8::gemm_phase(lds, g, S, E);
    }
    SEAM(2);
    if (IN(3)) {
        const bool conv_first = (blockIdx.x & 1) == 0;
#pragma unroll 1
        for (int st = 0; st < 2; ++st) {
            if ((st == 0) == conv_first) phase_conv1d(p); else phase_chunk_mlp(p, smem);
        }
    }
    SEAM(3);
    if (IN(4)) REPS(4) {
        __syncthreads();
        const Params q = load_params(); unsigned char* ws = q.ws; bf16_t* PX = (bf16_t*)(ws + WS_PX);
        pg8::GemmD g{(const bf16_t*)q.out, (const bf16_t*)(ws + WS_WG), WR, 256};
        SchedGate S{264, 264 * 20, G, c};
        EpiGate E{(const bf16_t*)q.out, (const float*)(ws + WS_SPT), (const float*)(ws + WS_SPT) + 2 * WR, (const float*)(ws + WS_SPT) + 4 * WR, (float2*)(ws + WS_AGG), PX,
                  (bf16_t*)(ws + WS_G3A), (bf16_t*)((unsigned char*)q.out + OUT_G3B)};
        pg8::gemm_phase(lds, g, S, E);
    }
    SEAM(4);
    if (IN(5)) REPS(5) phase_carry_fix(p, smem);
    SEAM(5);
    if (IN(7)) REPS(7) {
        __syncthreads();
        const Params q = load_params(); unsigned char* ws = q.ws; bf16_t* PX = (bf16_t*)(ws + WS_PX); float* MFIN = (float*)(ws + WS_MFIN); (void)PX; (void)MFIN;
        pg8::GemmD g{PX + OFF_RG, (const bf16_t*)(ws + WS_WPRG), NIN, 2304};
        SchedMerge S{G, c}; EpiMerge E{PX};
        pg8::gemm_phase(lds, g, S, E);
    }
    SEAM(7);
    if (IN(8)) REPS(8) {
        __syncthreads();
        const Params q = load_params(); unsigned char* ws = q.ws; bf16_t* PX = (bf16_t*)(ws + WS_PX); float* MFIN = (float*)(ws + WS_MFIN); (void)PX; (void)MFIN;
        pg8::GemmD g{PX, (const bf16_t*)(ws + WS_WOUT), NIN, DM};
        SchedPlain S{256, 4, 1024, G, c, 16}; EpiRes<false> E{q.in[0], (bf16_t*)q.out, MFIN + 2 * 1024};
        pg8::gemm_phase(lds, g, S, E);
    }
    SEAM(8);
    if (IN(9)) REPS(9) phase_norm<false>(p, smem);
    SEAM(9);
    if (IN(10)) REPS(10) {
        __syncthreads();
        const Params q = load_params(); unsigned char* ws = q.ws; bf16_t* PX = (bf16_t*)(ws + WS_PX); float* MFIN = (float*)(ws + WS_MFIN); (void)PX; (void)MFIN;
        pg8::GemmD g{(const bf16_t*)(ws + WS_H2), (const bf16_t*)(ws + WS_WUP), DM, DM};
        SchedPlain S{256, 22, 5632, G, c, 16}; EpiUp E{(bf16_t*)(ws + WS_UG), (bf16_t*)(ws + WS_UV)};
        pg8::gemm_phase(lds, g, S, E);
    }
    SEAM(10);
    if (IN(11)) REPS(11) phase_conv2d(p);
    SEAM(11);
    if (IN(12)) REPS(12) {
        __syncthreads();
        const Params q = load_params(); unsigned char* ws = q.ws; bf16_t* PX = (bf16_t*)(ws + WS_PX); float* MFIN = (float*)(ws + WS_MFIN); (void)PX; (void)MFIN;
        pg8::GemmD g{(const bf16_t*)(ws + WS_UV), (const bf16_t*)(ws + WS_WDN), DFF, DFF};
        SchedPlain S{256, 4, 1024, G, c, 44}; EpiRes<true> E{q.out, (bf16_t*)(ws + WS_H2), MFIN + 5 * 1024};
        pg8::gemm_phase(lds, g, S, E);
    }
    SEAM(12);
    if (IN(13)) REPS(13) phase_final(p);
}

extern "C" void kernel_launch(void* const* d_in, const int* in_sizes, int n_in, void* d_out, int out_size, void* d_ws, size_t ws_size, hipStream_t stream) {
    static int grid = 0;
    if (grid == 0) {
        if (n_in != 27 || ws_size < WS_NEED) { fprintf(stderr, "kernel_launch: unexpected n_in %d / ws %zu (need %zu)\n", n_in, ws_size, (size_t)WS_NEED); grid = -1; return; }
        int dev = 0, cus = 0, per_cu = 0;
        hipGetDevice(&dev); hipDeviceGetAttribute(&cus, hipDeviceAttributeMultiprocessorCount, dev);
        if (hipFuncSetAttribute((const void*)mega, hipFuncAttributeMaxDynamicSharedMemorySize, LDS_BYTES) != hipSuccess) { fprintf(stderr, "kernel_launch: hipFuncSetAttribute failed\n"); grid = -1; return; }
        hipOccupancyMaxActiveBlocksPerMultiprocessor(&per_cu, (const void*)mega, 512, LDS_BYTES);
        (void)hipGetLastError();
        if (per_cu < 1) fprintf(stderr, "kernel_launch: occupancy query says %d blocks/CU\n", per_cu);
        grid = cus > 0 ? cus : 256;
    }
    if (grid < 0) return;
    Params p{};
    for (int i = 0; i < 27; ++i) p.in[i] = (const float*)d_in[i];
    p.out = (float*)d_out; p.ws = (unsigned char*)d_ws;
    (void)hipMemsetAsync((unsigned char*)d_ws + WS_BAR, 0, (size_t)3456 * 4, stream);
#if ONE_LAUNCH
    p.ph_lo = 0; p.ph_hi = NPH;
    void* args[] = {&p};
    hipError_t e = hipLaunchCooperativeKernel((const void*)mega, dim3(grid), dim3(512), args, LDS_BYTES, stream);
    if (e != hipSuccess) fprintf(stderr, "cooperative launch failed: %s (grid %d)\n", hipGetErrorString(e), grid);
#else
    for (int ph = 0; ph < NPH; ++ph) { p.ph_lo = ph; p.ph_hi = ph + 1; hipLaunchKernelGGL(mega, dim3(grid), dim3(512), LDS_BYTES, stream, p); }
#endif
}
```

```cpp
#include <hip/hip_runtime.h>
#include <hip/hip_cooperative_groups.h>
#include <cstdio>
namespace cg = cooperative_groups;

#ifndef ONE_LAUNCH
#define ONE_LAUNCH 1
#endif

#define LAS __attribute__((address_space(3)))
typedef unsigned short bf16_t;
typedef short bf16x8 __attribute__((ext_vector_type(8)));
typedef float f32x4 __attribute__((ext_vector_type(4)));
typedef unsigned u32x4 __attribute__((ext_vector_type(4)));
typedef unsigned u32x2 __attribute__((ext_vector_type(2)));

constexpr int DM = 1024, NB = 8, SEQ = 8192, CTXL = 256, WR = 1280, NIN = 6656, DFF = 2816;
constexpr int MROWS = NB * SEQ;
constexpr int MCTX = NB * CTXL;
constexpr int NCH = 132;
constexpr int NPH = 14;
constexpr int LDS_BYTES = 131072 + 256;

constexpr size_t al256(size_t x) { return (x + 255) & ~(size_t)255; }
constexpr size_t WS_WIN = 0;
constexpr size_t WS_WG = WS_WIN + al256((size_t)NIN * DM * 2);
constexpr size_t WS_WPRG = WS_WG + al256((size_t)20 * 256 * 256 * 2);
constexpr size_t WS_WOUT = WS_WPRG + al256((size_t)1024 * 2304 * 2);
constexpr size_t WS_WUP = WS_WOUT + al256((size_t)1024 * 1024 * 2);
constexpr size_t WS_WDN = WS_WUP + al256((size_t)5632 * 1024 * 2);
constexpr size_t WS_WS = WS_WDN + al256((size_t)1024 * 2816 * 2);
constexpr size_t WS_MPART = WS_WS + al256((size_t)8 * 128 * 128 * 2);
constexpr size_t WS_MFIN = WS_MPART + al256((size_t)16 * 9 * 6144 * 4);
constexpr size_t WS_VSS = WS_MFIN + al256((size_t)9 * 6144 * 4);
constexpr size_t WS_AGG = WS_VSS + al256((size_t)MROWS * 16 * 4);
constexpr size_t WS_CARRY = WS_AGG + al256((size_t)NB * 2 * NCH * WR * 8);
constexpr size_t WS_PC = WS_CARRY + al256((size_t)NB * 2 * 128 * WR * 4);
constexpr size_t WS_SPT = WS_PC + al256((size_t)MCTX * WR * 2);
constexpr size_t WS_BAR = WS_SPT + al256((size_t)6 * WR * 4);
constexpr size_t WS_PX = WS_BAR + al256((size_t)3456 * 4);
constexpr size_t WS_END = WS_PX + (size_t)MROWS * NIN * 2;
constexpr size_t WS_H2 = WS_PX;
constexpr size_t WS_UG = WS_H2 + (size_t)MROWS * DM * 2;
constexpr size_t WS_UV = WS_UG + (size_t)MROWS * DFF * 2;
static_assert(WS_UV + (size_t)MROWS * DFF * 2 <= WS_END, "ffn buffers fit in px region");
static_assert(WS_H2 + (size_t)MROWS * DM * 2 <= WS_UV, "x2 (bf16) must not overlap the act buffer");
constexpr size_t WS_G3A = WS_END;
constexpr size_t G3_HALF_BYTES = (size_t)32768 * WR * 2;
constexpr size_t WS_NEED = WS_G3A + G3_HALF_BYTES;
constexpr size_t OUT_G3B = (size_t)(MROWS + MCTX) * WR * 2;
static_assert(OUT_G3B % 256 == 0 && OUT_G3B + G3_HALF_BYTES <= (size_t)MROWS * DM * 4, "g3 tail fits in d_out");
static_assert(WS_NEED <= (size_t)1073741824, "workspace fits");

constexpr int OFF_RG = 1280, OFF_U = 2560, OFF_V = 3584, OFF_GR = 4608, OFF_GG = 5632;

struct Params {
    const float* in[27];
    float* out;
    unsigned char* ws;
    int ph_lo, ph_hi;
};

__device__ __forceinline__ Params load_params() {
    const __attribute__((address_space(4))) unsigned long long* k = (const __attribute__((address_space(4))) unsigned long long*)__builtin_amdgcn_kernarg_segment_ptr();
    asm volatile("" : "+s"(k));
    Params q;
#pragma unroll
    for (int i = 0; i < 27; ++i) q.in[i] = (const float*)k[i];
    q.out = (float*)k[27]; q.ws = (unsigned char*)k[28]; q.ph_lo = 0; q.ph_hi = 0;
    return q;
}

__device__ __forceinline__ unsigned pk_bf16(float lo, float hi) { unsigned r; asm("v_cvt_pk_bf16_f32 %0, %1, %2" : "=v"(r) : "v"(lo), "v"(hi)); return r; }
__device__ __forceinline__ float bf_lo(unsigned w) { return __uint_as_float(w << 16); }
__device__ __forceinline__ float bf_hi(unsigned w) { return __uint_as_float(w & 0xffff0000u); }
__device__ __forceinline__ float sigmoidf_(float x) { return __builtin_amdgcn_rcpf(1.0f + __expf(-x)); }
__device__ __forceinline__ float gelu_t(float x) { return x * sigmoidf_(1.5957691216057308f * (x + 0.044715f * x * x * x)); }
typedef float f32x2 __attribute__((ext_vector_type(2)));
__device__ __forceinline__ f32x2 gelu_pk2(f32x2 x) {
    const f32x2 t = x * x;
    const f32x2 u = x * (t * (-0.044715f * 1.5957691216057308f * 1.4426950408889634f) + (-1.5957691216057308f * 1.4426950408889634f));
    f32x2 e; e.x = __builtin_amdgcn_exp2f(u.x); e.y = __builtin_amdgcn_exp2f(u.y);
    const f32x2 d = e + 1.0f;
    f32x2 r; r.x = __builtin_amdgcn_rcpf(d.x); r.y = __builtin_amdgcn_rcpf(d.y);
    return x * r;
}
__device__ __forceinline__ f32x2 sigmoid_pk2(f32x2 x) {
    const f32x2 u = x * (-1.4426950408889634f);
    f32x2 e; e.x = __builtin_amdgcn_exp2f(u.x); e.y = __builtin_amdgcn_exp2f(u.y);
    const f32x2 d = e + 1.0f;
    f32x2 r; r.x = __builtin_amdgcn_rcpf(d.x); r.y = __builtin_amdgcn_rcpf(d.y);
    return r;
}
struct Em1K { float c3, c4, c5, c6; };
__device__ __forceinline__ Em1K em1k_make() { Em1K k{0.16666667f, 0.041666668f, 0.008333334f, 0.0013888889f}; asm volatile("" : "+v"(k.c3), "+v"(k.c4), "+v"(k.c5), "+v"(k.c6)); return k; }
__device__ __forceinline__ float em1fk(float x, const Em1K& k) {
    const float p = x * (1.0f + x * (0.5f + x * (k.c3 + x * (k.c4 + x * (k.c5 + x * k.c6)))));
    return (__builtin_fabsf(x) < 0.25f) ? p : (__expf(x) - 1.0f);
}
__device__ __forceinline__ float em1f(float x) {
    const float p = x * (1.0f + x * (0.5f + x * (0.16666667f + x * (0.041666668f + x * (0.008333334f + x * 0.0013888889f)))));
    return (__builtin_fabsf(x) < 0.25f) ? p : (__expf(x) - 1.0f);
}
#define DPPF(old, src, ctrl) __int_as_float(__builtin_amdgcn_update_dpp(__float_as_int(old), __float_as_int(src), (ctrl), 0xf, 0xf, false))

#define SCAN_STEP(dir, n) \
    "v_fmac_f32_dpp %4, %4, %0 " dir ":" #n " row_mask:0xf bank_mask:0xf\n" \
    "v_fmac_f32_dpp %5, %5, %1 " dir ":" #n " row_mask:0xf bank_mask:0xf\n" \
    "v_fmac_f32_dpp %6, %6, %2 " dir ":" #n " row_mask:0xf bank_mask:0xf\n" \
    "v_fmac_f32_dpp %7, %7, %3 " dir ":" #n " row_mask:0xf bank_mask:0xf\n" \
    "v_mul_f32_dpp %0, %0, %0 " dir ":" #n " row_mask:0xf bank_mask:0xf\n" \
    "v_mul_f32_dpp %1, %1, %1 " dir ":" #n " row_mask:0xf bank_mask:0xf\n" \
    "v_mul_f32_dpp %2, %2, %2 " dir ":" #n " row_mask:0xf bank_mask:0xf\n" \
    "v_mul_f32_dpp %3, %3, %3 " dir ":" #n " row_mask:0xf bank_mask:0xf\n"
__device__ __forceinline__ void row_scan4_fwd(float& a0, float& a1, float& a2, float& a3, float& b0, float& b1, float& b2, float& b3) {
    asm volatile("s_nop 1\n" SCAN_STEP("row_shr", 1) SCAN_STEP("row_shr", 2) SCAN_STEP("row_shr", 4) SCAN_STEP("row_shr", 8)
                 : "+v"(a0), "+v"(a1), "+v"(a2), "+v"(a3), "+v"(b0), "+v"(b1), "+v"(b2), "+v"(b3));
}
__device__ __forceinline__ void row_scan4_bwd(float& a0, float& a1, float& a2, float& a3, float& b0, float& b1, float& b2, float& b3) {
    asm volatile("s_nop 1\n" SCAN_STEP("row_shl", 1) SCAN_STEP("row_shl", 2) SCAN_STEP("row_shl", 4) SCAN_STEP("row_shl", 8)
                 : "+v"(a0), "+v"(a1), "+v"(a2), "+v"(a3), "+v"(b0), "+v"(b1), "+v"(b2), "+v"(b3));
}

namespace pg8 {
constexpr int BM = 256, BK = 64, HALF = 128, HTB = HALF * BK * 2, NXCD = 8, WGM = 8;
__device__ __forceinline__ int lds_byte(int r, int c) { const int st = (r >> 4) * 2 + (c >> 5), rr = r & 15, cc = c & 31, ob = rr * 64 + cc * 2; return st * 1024 + (ob ^ (((ob >> 9) & 1) << 5)); }
__device__ __forceinline__ void stage_rc(int b, int& R, int& C) { const int st = b / 1024, sb = b % 1024, swz = sb ^ (((sb >> 9) & 1) << 5); R = (st >> 1) * 16 + swz / 64; C = (st & 1) * 32 + (swz % 64) / 2; }
__device__ __forceinline__ int perm32(int rho) { const int n = rho >> 4, i = rho & 15; return 8 * (i >> 2) + 4 * n + (i & 3); }

struct Unit { int pm, pn, ka0, kb0, nkt, tag; };
struct GemmD { const bf16_t* A; const bf16_t* Bt; int lda, ldb; };

__device__ __forceinline__ void tile_map(int L, int nM, int nN, int nwg, int& pm, int& pn) {
    int wgid = L; { const int q = nwg / NXCD, r = nwg % NXCD, xcd = wgid % NXCD, off = wgid / NXCD; wgid = (xcd < r ? xcd * (q + 1) : r * (q + 1) + (xcd - r) * q) + off; }
    const int nig = WGM * nN, gid = wgid / nig, fm = gid * WGM, gsz = (nM - fm) < WGM ? (nM - fm) : WGM;
    pm = fm + ((wgid % nig) % gsz); pn = (wgid % nig) / gsz;
}

template <class Epi, class Sched, bool ALIGN_EPI = true, bool SP2 = true>
__device__ __forceinline__ void gemm_phase(LAS unsigned char* lds, const GemmD g, const Sched& S, const Epi& E) {
    const int tid = threadIdx.x, wid = __builtin_amdgcn_readfirstlane(tid >> 6), lane = tid & 63, wr = wid >> 2, wc = wid & 3, fr = lane & 15, fq = lane >> 4;
    unsigned voffA[2], voffB[2];
#pragma unroll
    for (int i = 0; i < 2; ++i) { int R, C; stage_rc(tid * 16 + i * 8192, R, C); const int Rb = Epi::PERM ? ((R & ~31) + perm32(R & 31)) : R;
        voffA[i] = (unsigned)(R * g.lda + C) * 2u; voffB[i] = (unsigned)(Rb * g.ldb + C) * 2u; }
    const size_t kstep = (size_t)(BK * 2);
    const size_t hstepA = (size_t)HALF * g.lda * 2, hstepB = (size_t)HALF * g.ldb * 2;
    const unsigned ldsw = (unsigned)wid * 1024u;
    const int aoff = lds_byte(wr * 64 + fr, fq * 8), boff = lds_byte(wc * 32 + fr, fq * 8);
#define PG8_SA(b, h) (((b) * 2 + (h)) * HTB)
#define PG8_SB(b, h) ((4 + (b) * 2 + (h)) * HTB)
#define PG8_STAGE(bufoff, gbase, voff) do { _Pragma("unroll") for (int _i = 0; _i < 2; ++_i) \
        __builtin_amdgcn_global_load_lds((const unsigned*)((const char*)(gbase) + (voff)[_i]), (LAS unsigned*)(lds + (bufoff) + ldsw + _i * 8192), 16, 0, 0); } while (0)
#define PG8_LDA(dst, b, h) do { _Pragma("unroll") for (int m = 0; m < 4; ++m) _Pragma("unroll") for (int k = 0; k < 2; ++k) dst[m][k] = *(const LAS bf16x8*)(lds + PG8_SA(b, h) + aoff + m * 2048 + k * 1024); } while (0)
#define PG8_LDB(dst, b, h) do { _Pragma("unroll") for (int n = 0; n < 2; ++n) _Pragma("unroll") for (int k = 0; k < 2; ++k) dst[n][k] = *(const LAS bf16x8*)(lds + PG8_SB(b, h) + boff + n * 2048 + k * 1024); } while (0)
#define PG8_MMA(ai, bj, At, Bt) do { __builtin_amdgcn_s_setprio(1); _Pragma("unroll") for (int m = 0; m < 4; ++m) _Pragma("unroll") for (int n = 0; n < 2; ++n) _Pragma("unroll") for (int k = 0; k < 2; ++k) \
        acc[ai][bj][m][n] = __builtin_amdgcn_mfma_f32_16x16x32_bf16(Bt[n][k], At[m][k], acc[ai][bj][m][n], 0, 0, 0); __builtin_amdgcn_s_setprio(0); } while (0)
#define PG8_WAIT_V(n) asm volatile("s_waitcnt vmcnt(" #n ")" ::: "memory")
#define PG8_WAIT_L(n) asm volatile("s_waitcnt lgkmcnt(" #n ")" ::: "memory")
#define PG8_BAR __builtin_amdgcn_s_barrier()
#define PG8_SCHED __builtin_amdgcn_sched_barrier(0)
    Unit cur, nxt; int ui = 0;
    if (!S.next(0, cur)) return;
    f32x4 acc[2][2][4][2];
#pragma unroll
    for (int a = 0; a < 2; ++a)
#pragma unroll
        for (int b = 0; b < 2; ++b)
#pragma unroll
            for (int m = 0; m < 4; ++m)
#pragma unroll
                for (int n = 0; n < 2; ++n) acc[a][b][m][n] = (f32x4){0.f, 0.f, 0.f, 0.f};
    bf16x8 At[4][2], B0[2][2], B1[2][2];
    typename Epi::Pre pre;
    E.prefetch(pre, cur, wr, wc, fr, fq);
    const char* cA = (const char*)g.A + (size_t)cur.pm * 2 * hstepA + (size_t)cur.ka0 * kstep;
    const char* cB = (const char*)g.Bt + (size_t)cur.pn * 2 * hstepB + (size_t)cur.kb0 * kstep;
    if constexpr (SP2) {
        PG8_STAGE(PG8_SB(0, 0), cB, voffB); PG8_STAGE(PG8_SB(0, 1), cB + hstepB, voffB); PG8_STAGE(PG8_SA(0, 0), cA, voffA); PG8_STAGE(PG8_SA(0, 1), cA + hstepA, voffA);
        if (wr == 1) PG8_BAR;
        PG8_WAIT_V(2); PG8_BAR;
        PG8_STAGE(PG8_SB(1, 0), cB + kstep, voffB); PG8_STAGE(PG8_SA(1, 0), cA + kstep, voffA); PG8_STAGE(PG8_SB(1, 1), cB + hstepB + kstep, voffB);
        PG8_WAIT_V(6); PG8_BAR;
    } else {
        PG8_STAGE(PG8_SB(0, 0), cB, voffB); PG8_STAGE(PG8_SA(0, 0), cA, voffA); PG8_STAGE(PG8_SB(0, 1), cB + hstepB, voffB); PG8_STAGE(PG8_SA(0, 1), cA + hstepA, voffA);
        if (wr == 1) PG8_BAR;
        PG8_WAIT_V(4); PG8_BAR;
        PG8_STAGE(PG8_SB(1, 0), cB + kstep, voffB); PG8_STAGE(PG8_SA(1, 0), cA + kstep, voffA); PG8_STAGE(PG8_SB(1, 1), cB + hstepB + kstep, voffB);
        PG8_WAIT_V(6); PG8_BAR;
    }
    for (;;) {
        const bool has_next = S.next(ui + 1, nxt);
        const char* nA = has_next ? (const char*)g.A + (size_t)nxt.pm * 2 * hstepA + (size_t)nxt.ka0 * kstep : cA;
        const char* nB = has_next ? (const char*)g.Bt + (size_t)nxt.pn * 2 * hstepB + (size_t)nxt.kb0 * kstep : cB;
        const int nt = cur.nkt;
#pragma unroll 1
        for (int t = 0; t < nt; t += 2) {
            const bool last = (t == nt - 2);
            const char* a1 = cA + (size_t)(t + 1) * kstep;
            const char* a2 = last ? nA : cA + (size_t)(t + 2) * kstep; const char* b2 = last ? nB : cB + (size_t)(t + 2) * kstep;
            const char* a3 = a2 + kstep; const char* b3 = b2 + kstep;
            if constexpr (SP2) {
            PG8_LDB(B0, 0, 0); PG8_LDB(B1, 0, 1); PG8_SCHED; PG8_LDA(At, 0, 0); PG8_STAGE(PG8_SA(1, 1), a1 + hstepA, voffA);
            PG8_WAIT_V(8); PG8_WAIT_L(0); PG8_BAR; PG8_MMA(0, 0, At, B0); PG8_MMA(0, 1, At, B1); PG8_BAR; PG8_SCHED;
            PG8_LDA(At, 0, 1); PG8_STAGE(PG8_SB(0, 0), b2, voffB); PG8_STAGE(PG8_SB(0, 1), b2 + hstepB, voffB); PG8_STAGE(PG8_SA(0, 0), a2, voffA);
            PG8_WAIT_V(8); PG8_WAIT_L(0); PG8_BAR; PG8_MMA(1, 0, At, B0); PG8_MMA(1, 1, At, B1); PG8_BAR; PG8_SCHED;
            PG8_LDB(B0, 1, 0); PG8_LDB(B1, 1, 1); PG8_SCHED; PG8_LDA(At, 1, 0); PG8_STAGE(PG8_SA(0, 1), a2 + hstepA, voffA);
            PG8_WAIT_V(8); PG8_WAIT_L(0); PG8_BAR; PG8_MMA(0, 0, At, B0); PG8_MMA(0, 1, At, B1); PG8_BAR; PG8_SCHED;
            PG8_LDA(At, 1, 1); PG8_STAGE(PG8_SB(1, 0), b3, voffB); PG8_STAGE(PG8_SB(1, 1), b3 + hstepB, voffB); PG8_STAGE(PG8_SA(1, 0), a3, voffA);
            PG8_WAIT_V(8); PG8_WAIT_L(0); PG8_BAR; PG8_MMA(1, 0, At, B0); PG8_MMA(1, 1, At, B1); PG8_BAR; PG8_SCHED;
            } else {
            PG8_LDB(B0, 0, 0); PG8_SCHED; PG8_LDA(At, 0, 0); PG8_STAGE(PG8_SA(1, 1), a1 + hstepA, voffA);
            PG8_WAIT_L(8); PG8_BAR; PG8_WAIT_L(0); PG8_MMA(0, 0, At, B0); PG8_BAR; PG8_SCHED;
            PG8_LDB(B1, 0, 1); PG8_STAGE(PG8_SB(0, 0), b2, voffB);
            PG8_BAR; PG8_WAIT_L(0); PG8_MMA(0, 1, At, B1); PG8_BAR;
            PG8_LDA(At, 0, 1); PG8_STAGE(PG8_SA(0, 0), a2, voffA);
            PG8_BAR; PG8_WAIT_L(0); PG8_MMA(1, 0, At, B0); PG8_BAR; PG8_SCHED;
            PG8_STAGE(PG8_SB(0, 1), b2 + hstepB, voffB);
            PG8_WAIT_V(6); PG8_BAR; PG8_MMA(1, 1, At, B1); PG8_BAR;
            PG8_LDB(B0, 1, 0); PG8_SCHED; PG8_LDA(At, 1, 0); PG8_STAGE(PG8_SA(0, 1), a2 + hstepA, voffA);
            PG8_WAIT_L(8); PG8_BAR; PG8_WAIT_L(0); PG8_MMA(0, 0, At, B0); PG8_BAR; PG8_SCHED;
            PG8_LDB(B1, 1, 1); PG8_STAGE(PG8_SB(1, 0), b3, voffB);
            PG8_BAR; PG8_WAIT_L(0); PG8_MMA(0, 1, At, B1); PG8_BAR;
            PG8_LDA(At, 1, 1); PG8_STAGE(PG8_SA(1, 0), a3, voffA);
            PG8_BAR; PG8_WAIT_L(0); PG8_MMA(1, 0, At, B0); PG8_BAR; PG8_SCHED;
            PG8_STAGE(PG8_SB(1, 1), b3 + hstepB, voffB);
            PG8_WAIT_V(6); PG8_BAR; PG8_MMA(1, 1, At, B1); PG8_BAR;
            }
        }
        if constexpr (ALIGN_EPI) { if (wr == 0) PG8_BAR; }
        int efr = fr, efq = fq; asm volatile("" : "+v"(efr), "+v"(efq));
        const bool zero = E(acc, cur, wr, wc, efr, efq, pre);
        if (has_next) E.prefetch(pre, nxt, wr, wc, efr, efq);
        if (!has_next) break;
        if (zero) {
#pragma unroll
            for (int a = 0; a < 2; ++a)
#pragma unroll
                for (int b = 0; b < 2; ++b)
#pragma unroll
                    for (int m = 0; m < 4; ++m)
#pragma unroll
                        for (int n = 0; n < 2; ++n) acc[a][b][m][n] = (f32x4){0.f, 0.f, 0.f, 0.f};
        }
        cur = nxt; cA = nA; cB = nB; ++ui;
        if constexpr (ALIGN_EPI) { if (wr == 1) PG8_BAR; }
    }
    PG8_WAIT_V(0);
    if constexpr (!ALIGN_EPI) { if (wr == 0) PG8_BAR; }
    PG8_BAR;
#undef PG8_SA
#undef PG8_SB
#undef PG8_STAGE
#undef PG8_LDA
#undef PG8_LDB
#undef PG8_MMA
#undef PG8_WAIT_V
#undef PG8_WAIT_L
#undef PG8_BAR
#undef PG8_SCHED
}
}
using pg8::Unit;

struct SchedPlain {
    int nM, nN, nwg, G, c, nkt;
    __device__ __forceinline__ bool next(int i, Unit& u) const {
        const long L = (long)i * G + c; if (L >= nwg) return false;
        pg8::tile_map((int)L, nM, nN, nwg, u.pm, u.pn); u.ka0 = 0; u.kb0 = 0; u.nkt = nkt; u.tag = 0; return true; }
};
struct SchedIn {
    int G, c;
    __device__ __forceinline__ bool next(int i, Unit& u) const {
        const long L = (long)i * G + c; if (L >= 6656 + 40) return false;
        if (L < 6656) pg8::tile_map((int)L, 256, 26, 6656, u.pm, u.pn);
        else { const int e = (int)L - 6656; u.pm = 256 + e / 5; u.pn = e % 5; }
        u.ka0 = 0; u.kb0 = 0; u.nkt = 16; u.tag = 0; return true; }
};
struct SchedMerge {
    int G, c;
    __device__ __forceinline__ bool next(int i, Unit& u) const {
        const long L = (long)(i >> 1) * G + c; if (L >= 1024) return false;
        pg8::tile_map((int)L, 256, 4, 1024, u.pm, u.pn); const int part = i & 1;
        u.ka0 = part ? 20 : 0; u.kb0 = u.ka0; u.nkt = part ? 16 : 20; u.tag = part; return true; }
};
struct SchedGate {
    int nM, nwg, G, c;
    __device__ __forceinline__ bool next(int i, Unit& u) const {
        const long L = (long)i * G + c; if (L >= nwg) return false;
        pg8::tile_map((int)L, nM, 20, nwg, u.pm, u.pn); u.ka0 = (u.pn >> 2) * 4; u.kb0 = 0; u.nkt = 4; u.tag = 0; return true; }
};

struct EpiIn {
    static constexpr bool PERM = true;
    bf16_t* PX; bf16_t* PC; float* VSS;
    struct Pre {}; __device__ __forceinline__ void prefetch(Pre&, const Unit&, int, int, int, int) const {}
    __device__ __forceinline__ bool operator()(f32x4 (&acc)[2][2][4][2], const Unit& u, int wr, int wc, int fr, int fq, const Pre& pre) const {
        const int pn = u.pn;
        const int mode = (u.pm >= 256) ? 0 : ((pn >= 5 && pn < 10) ? 1 : ((pn >= 14 && pn < 18) ? 2 : 0));
#pragma unroll
        for (int ai = 0; ai < 2; ++ai)
#pragma unroll
            for (int m = 0; m < 4; ++m) {
                const int r = u.pm * 256 + ai * 128 + wr * 64 + m * 16 + fr;
                float ss = 0.f;
#pragma unroll
                for (int bj = 0; bj < 2; ++bj) {
                    const int c0 = pn * 256 + bj * 128 + wc * 32 + fq * 8;
                    f32x2 v2[4];
#pragma unroll
                    for (int n = 0; n < 2; ++n)
#pragma unroll
                        for (int jp = 0; jp < 2; ++jp) {
                            f32x2 x = {acc[ai][bj][m][n][2 * jp], acc[ai][bj][m][n][2 * jp + 1]};
                            if (mode == 1 || mode == 2) x = gelu_pk2(x);
                            else if (mode == 3) x = sigmoid_pk2(x);
                            if (mode == 2) ss += x.x * x.x + x.y * x.y;
                            v2[n * 2 + jp] = x;
                        }
                    const float v[8] = {v2[0].x, v2[0].y, v2[1].x, v2[1].y, v2[2].x, v2[2].y, v2[3].x, v2[3].y};
                    u32x4 w; w.x = pk_bf16(v[0], v[1]); w.y = pk_bf16(v[2], v[3]); w.z = pk_bf16(v[4], v[5]); w.w = pk_bf16(v[6], v[7]);
                    if (u.pm < 256) *(u32x4*)(PX + (size_t)r * NIN + c0) = w;
                    else *(u32x4*)(PC + (size_t)(r - MROWS) * WR + c0) = w;
                }
                if (mode == 2) {
                    ss += __shfl_xor(ss, 16); ss += __shfl_xor(ss, 32);
                    if (fq == 0) VSS[(size_t)r * 16 + (pn - 14) * 4 + wc] = ss;
                }
            }
        return true;
    }
};

struct EpiMerge {
    static constexpr bool PERM = true;
    bf16_t* PX;
    struct Pre {}; __device__ __forceinline__ void prefetch(Pre&, const Unit&, int, int, int, int) const {}
    __device__ __forceinline__ bool operator()(f32x4 (&acc)[2][2][4][2], const Unit& u, int wr, int wc, int fr, int fq, const Pre& pre) const {
#pragma unroll
        for (int ai = 0; ai < 2; ++ai) {
            u32x4 gg[4][2], gr[4][2];
#pragma unroll
            for (int m = 0; m < 4; ++m)
#pragma unroll
                for (int bj = 0; bj < 2; ++bj) {
                    const int r = u.pm * 256 + ai * 128 + wr * 64 + m * 16 + fr, c0 = u.pn * 256 + bj * 128 + wc * 32 + fq * 8;
                    gg[m][bj] = *(const u32x4*)(PX + (size_t)r * NIN + OFF_GG + c0);
                    if (u.tag == 0) gr[m][bj] = *(const u32x4*)(PX + (size_t)r * NIN + OFF_GR + c0);
                }
#pragma unroll
            for (int m = 0; m < 4; ++m)
#pragma unroll
                for (int bj = 0; bj < 2; ++bj) {
                    const int r = u.pm * 256 + ai * 128 + wr * 64 + m * 16 + fr, c0 = u.pn * 256 + bj * 128 + wc * 32 + fq * 8;
                    const u32x4 ggv = gg[m][bj];
                    const float zg[8] = {bf_lo(ggv.x), bf_hi(ggv.x), bf_lo(ggv.y), bf_hi(ggv.y), bf_lo(ggv.z), bf_hi(ggv.z), bf_lo(ggv.w), bf_hi(ggv.w)};
                    float dg[8];
#pragma unroll
                    for (int k = 0; k < 8; ++k) dg[k] = 1.0f + __builtin_amdgcn_exp2f(fmaxf(zg[k], -60.0f) * -1.4426950408889634f);
                    if (u.tag == 0) {
                        const u32x4 grv = gr[m][bj];
                        const float zr[8] = {bf_lo(grv.x), bf_hi(grv.x), bf_lo(grv.y), bf_hi(grv.y), bf_lo(grv.z), bf_hi(grv.z), bf_lo(grv.w), bf_hi(grv.w)};
#pragma unroll
                        for (int n = 0; n < 2; ++n)
#pragma unroll
                            for (int j = 0; j < 4; ++j) acc[ai][bj][m][n][j] *= dg[n * 4 + j] * __builtin_amdgcn_rcpf(1.0f + __builtin_amdgcn_exp2f(zr[n * 4 + j] * -1.4426950408889634f));
                    } else {
                        float v[8];
#pragma unroll
                        for (int n = 0; n < 2; ++n)
#pragma unroll
                            for (int j = 0; j < 4; ++j) v[n * 4 + j] = acc[ai][bj][m][n][j] * __builtin_amdgcn_rcpf(dg[n * 4 + j]);
                        u32x4 w; w.x = pk_bf16(v[0], v[1]); w.y = pk_bf16(v[2], v[3]); w.z = pk_bf16(v[4], v[5]); w.w = pk_bf16(v[6], v[7]);
                        *(u32x4*)(PX + (size_t)r * NIN + c0) = w;
                    }
                }
        }
        return u.tag != 0;
    }
};

template <bool RES_BF16> struct EpiRes {
    static constexpr bool PERM = true;
    const void* res; bf16_t* out; const float* gate;
    struct Pre {}; __device__ __forceinline__ void prefetch(Pre&, const Unit&, int, int, int, int) const {}
    __device__ __forceinline__ bool operator()(f32x4 (&acc)[2][2][4][2], const Unit& u, int wr, int wc, int fr, int fq, const Pre& pre) const {
        const int b = u.pm >> 5;
        f32x4 gv[2][2];
#pragma unroll
        for (int bj = 0; bj < 2; ++bj)
#pragma unroll
            for (int n = 0; n < 2; ++n) gv[bj][n] = *(const f32x4*)(gate + (size_t)b * 6144 + u.pn * 256 + bj * 128 + wc * 32 + fq * 8 + n * 4);
        u32x4 rball[2][4][2];
        if (RES_BF16) {
#pragma unroll
            for (int ai = 0; ai < 2; ++ai)
#pragma unroll
                for (int m = 0; m < 4; ++m)
#pragma unroll
                    for (int bj = 0; bj < 2; ++bj)
                        rball[ai][m][bj] = *(const u32x4*)((const bf16_t*)res + (size_t)(u.pm * 256 + ai * 128 + wr * 64 + m * 16 + fr) * DM + u.pn * 256 + bj * 128 + wc * 32 + fq * 8);
        }
#pragma unroll
        for (int ai = 0; ai < 2; ++ai) {
            u32x4 rb[4][2]; f32x4 rf[4][2][2];
#pragma unroll
            for (int m = 0; m < 4; ++m)
#pragma unroll
                for (int bj = 0; bj < 2; ++bj) {
                    const size_t o = (size_t)(u.pm * 256 + ai * 128 + wr * 64 + m * 16 + fr) * DM + u.pn * 256 + bj * 128 + wc * 32 + fq * 8;
                    if (RES_BF16) rb[m][bj] = rball[ai][m][bj];
                    else { rf[m][bj][0] = *(const f32x4*)((const float*)res + o); rf[m][bj][1] = *(const f32x4*)((const float*)res + o + 4); }
                }
#pragma unroll
            for (int m = 0; m < 4; ++m)
#pragma unroll
                for (int bj = 0; bj < 2; ++bj) {
                    const size_t o = (size_t)(u.pm * 256 + ai * 128 + wr * 64 + m * 16 + fr) * DM + u.pn * 256 + bj * 128 + wc * 32 + fq * 8;
                    f32x4 x0, x1;
                    if (RES_BF16) { const u32x4 xr = rb[m][bj];
                        x0 = (f32x4){bf_lo(xr.x), bf_hi(xr.x), bf_lo(xr.y), bf_hi(xr.y)}; x1 = (f32x4){bf_lo(xr.z), bf_hi(xr.z), bf_lo(xr.w), bf_hi(xr.w)}; }
                    else { x0 = rf[m][bj][0]; x1 = rf[m][bj][1]; }
                    const f32x4 y0 = x0 + gv[bj][0] * acc[ai][bj][m][0], y1 = x1 + gv[bj][1] * acc[ai][bj][m][1];
                    u32x4 w; w.x = pk_bf16(y0.x, y0.y); w.y = pk_bf16(y0.z, y0.w); w.z = pk_bf16(y1.x, y1.y); w.w = pk_bf16(y1.z, y1.w);
                    *(u32x4*)(out + o) = w;
                }
        }
        return true;
    }
};

struct EpiUp {
    static constexpr bool PERM = true;
    bf16_t* UG; bf16_t* UV;
    struct Pre {}; __device__ __forceinline__ void prefetch(Pre&, const Unit&, int, int, int, int) const {}
    __device__ __forceinline__ bool operator()(f32x4 (&acc)[2][2][4][2], const Unit& u, int wr, int wc, int fr, int fq, const Pre& pre) const {
        bf16_t* base = u.pn < 11 ? UG : UV; const int pn = u.pn < 11 ? u.pn : u.pn - 11;
#pragma unroll
        for (int ai = 0; ai < 2; ++ai)
#pragma unroll
            for (int m = 0; m < 4; ++m) {
                const int r = u.pm * 256 + ai * 128 + wr * 64 + m * 16 + fr;
#pragma unroll
                for (int bj = 0; bj < 2; ++bj) {
                    const int c0 = pn * 256 + bj * 128 + wc * 32 + fq * 8;
                    u32x4 w; w.x = pk_bf16(acc[ai][bj][m][0][0], acc[ai][bj][m][0][1]); w.y = pk_bf16(acc[ai][bj][m][0][2], acc[ai][bj][m][0][3]);
                    w.z = pk_bf16(acc[ai][bj][m][1][0], acc[ai][bj][m][1][1]); w.w = pk_bf16(acc[ai][bj][m][1][2], acc[ai][bj][m][1][3]);
                    *(u32x4*)(base + (size_t)r * DFF + c0) = w;
                }
            }
        return true;
    }
};

struct EpiGate {
    static constexpr bool PERM = false;
    const bf16_t* XR; const float* ba; const float* bx; const float* lam;
    float2* AGG; bf16_t* PX; bf16_t* G3A; bf16_t* G3B;
    struct Pre { u32x2 x[2][4]; };
    __device__ __forceinline__ void prefetch(Pre& pre, const Unit& u, int wr, int wc, int fr, int fq) const {
        const int ch = u.pn * 64 + wc * 16 + fq * 4;
#pragma unroll
        for (int ai = 0; ai < 2; ++ai)
#pragma unroll
            for (int m = 0; m < 4; ++m) pre.x[ai][m] = *(const u32x2*)(XR + (size_t)(u.pm * 256 + ai * 128 + wr * 64 + m * 16 + fr) * WR + ch);
    }
    __device__ __forceinline__ bool operator()(f32x4 (&acc)[2][2][4][2], const Unit& u, int wr, int wc, int fr, int fq, const Pre& pre) const {
        const int lane = fq * 16 + fr;
        const int ch = u.pn * 64 + wc * 16 + fq * 4;
        const bool isctx = u.pm >= 256;
        const int b = isctx ? (u.pm - 256) : (u.pm >> 5);
        f32x4 tb[2][3];
#pragma unroll
        for (int bj = 0; bj < 2; ++bj) { tb[bj][0] = *(const f32x4*)(ba + bj * WR + ch); tb[bj][1] = *(const f32x4*)(bx + bj * WR + ch); tb[bj][2] = *(const f32x4*)(lam + bj * WR + ch); }
        u32x2 rgv[2][4];
        if (!isctx) {
#pragma unroll
            for (int ai = 0; ai < 2; ++ai)
#pragma unroll
                for (int m = 0; m < 4; ++m) rgv[ai][m] = *(const u32x2*)(PX + (size_t)(u.pm * 256 + ai * 128 + wr * 64 + m * 16 + fr) * NIN + OFF_RG + ch);
        }
#pragma unroll
        for (int ai = 0; ai < 2; ++ai) {
            const int row0 = u.pm * 256 + ai * 128 + wr * 64;
            const int cidx = isctx ? (ai * 2 + wr) : (4 + (u.pm & 31) * 4 + ai * 2 + wr);
            u32x2 xrv[4];
#pragma unroll
            for (int m = 0; m < 4; ++m) xrv[m] = pre.x[ai][m];
#pragma unroll
            for (int bj = 0; bj < 2; ++bj) {
                const f32x4 bav = tb[bj][0], bxv = tb[bj][1], sp = tb[bj][2];
#pragma unroll
                for (int m = 0; m < 4; ++m) {
                    float av[4], bv[4];
                    const f32x4 xv4 = {bf_lo(xrv[m].x), bf_hi(xrv[m].x), bf_lo(xrv[m].y), bf_hi(xrv[m].y)};
#pragma unroll
                    for (int jp = 0; jp < 2; ++jp) {
                        const f32x2 z0 = {acc[ai][bj][m][0][2 * jp], acc[ai][bj][m][0][2 * jp + 1]}, z1 = {acc[ai][bj][m][1][2 * jp], acc[ai][bj][m][1][2 * jp + 1]};
                        const f32x2 ba2 = {bav[2 * jp], bav[2 * jp + 1]}, bx2 = {bxv[2 * jp], bxv[2 * jp + 1]}, sp2 = {sp[2 * jp], sp[2 * jp + 1]}, xv2 = {xv4[2 * jp], xv4[2 * jp + 1]};
                        const f32x2 u0 = z0 * (-1.4426950408889634f) + ba2, u1 = z1 * (-1.4426950408889634f) + bx2;
                        f32x2 e0, e1; e0.x = __builtin_amdgcn_exp2f(u0.x); e0.y = __builtin_amdgcn_exp2f(u0.y); e1.x = __builtin_amdgcn_exp2f(u1.x); e1.y = __builtin_amdgcn_exp2f(u1.y);
                        const f32x2 d0 = e0 + 1.0f, d1 = e1 + 1.0f;
                        f32x2 rg, ig; rg.x = __builtin_amdgcn_rcpf(d0.x); rg.y = __builtin_amdgcn_rcpf(d0.y); ig.x = __builtin_amdgcn_rcpf(d1.x); ig.y = __builtin_amdgcn_rcpf(d1.y);
                        const f32x2 la = sp2 * rg;
                        f32x2 a; a.x = __builtin_amdgcn_exp2f(la.x); a.y = __builtin_amdgcn_exp2f(la.y);
                        const f32x2 om = 1.0f - a * a;
                        f32x2 mult; mult.x = __builtin_amdgcn_sqrtf(om.x); mult.y = __builtin_amdgcn_sqrtf(om.y);
                        const f32x2 bb = mult * (ig * xv2);
                        av[2 * jp] = a.x; av[2 * jp + 1] = a.y; bv[2 * jp] = bb.x; bv[2 * jp + 1] = bb.y;
                    }
                    if (bj == 0) row_scan4_fwd(av[0], av[1], av[2], av[3], bv[0], bv[1], bv[2], bv[3]);
                    else row_scan4_bwd(av[0], av[1], av[2], av[3], bv[0], bv[1], bv[2], bv[3]);
#pragma unroll
                    for (int j = 0; j < 4; ++j) { acc[ai][bj][m][0][j] = av[j]; acc[ai][bj][m][1][j] = bv[j]; }
                }
                float hin[4] = {0.f, 0.f, 0.f, 0.f}, pin[4] = {1.f, 1.f, 1.f, 1.f};
                const int srcl = (lane & 48) | (bj == 0 ? 15 : 0);
#pragma unroll
                for (int mm = 0; mm < 4; ++mm) { const int m = (bj == 0) ? mm : 3 - mm;
#pragma unroll
                    for (int j = 0; j < 4; ++j) {
                        const float h = __builtin_fmaf(acc[ai][bj][m][0][j], hin[j], acc[ai][bj][m][1][j]);
                        const float P = acc[ai][bj][m][0][j] * pin[j];
                        acc[ai][bj][m][1][j] = h; acc[ai][bj][m][0][j] = P;
                        hin[j] = __shfl(h, srcl); pin[j] = __shfl(P, srcl);
                    } }
                if (fr == (bj == 0 ? 15 : 0)) {
                    float2* dst = AGG + ((size_t)(b * 2 + bj) * NCH + cidx) * WR + ch;
                    *(f32x4*)(dst) = (f32x4){pin[0], hin[0], pin[1], hin[1]};
                    *(f32x4*)(dst + 2) = (f32x4){pin[2], hin[2], pin[3], hin[3]};
                }
            }
            if (!isctx) {
                const bool odd = (fq & 1) != 0;
                const int chp = ch & ~7;
#pragma unroll
                for (int k = 0; k < 2; ++k) {
                    u32x2 w1[2], w2[2], w3[2];
#pragma unroll
                    for (int e = 0; e < 2; ++e) {
                        const int m = 2 * k + e;
                        const u32x2 gv = rgv[ai][m];
                        const float g0 = bf_lo(gv.x), g1 = bf_hi(gv.x), g2 = bf_lo(gv.y), g3 = bf_hi(gv.y);
                        w1[e].x = pk_bf16(g0 * (acc[ai][0][m][1][0] + acc[ai][1][m][1][0]), g1 * (acc[ai][0][m][1][1] + acc[ai][1][m][1][1]));
                        w1[e].y = pk_bf16(g2 * (acc[ai][0][m][1][2] + acc[ai][1][m][1][2]), g3 * (acc[ai][0][m][1][3] + acc[ai][1][m][1][3]));
                        w2[e].x = pk_bf16(g0 * acc[ai][0][m][0][0], g1 * acc[ai][0][m][0][1]); w2[e].y = pk_bf16(g2 * acc[ai][0][m][0][2], g3 * acc[ai][0][m][0][3]);
                        w3[e].x = pk_bf16(g0 * acc[ai][1][m][0][0], g1 * acc[ai][1][m][0][1]); w3[e].y = pk_bf16(g2 * acc[ai][1][m][0][2], g3 * acc[ai][1][m][0][3]);
                    }
                    const int row = row0 + (2 * k + (odd ? 1 : 0)) * 16 + fr;
                    const u32x2 s1 = odd ? w1[0] : w1[1], s2 = odd ? w2[0] : w2[1], s3 = odd ? w3[0] : w3[1];
                    const u32x2 k1 = odd ? w1[1] : w1[0], k2 = odd ? w2[1] : w2[0], k3 = odd ? w3[1] : w3[0];
                    u32x2 r1, r2, r3;
                    r1.x = __shfl_xor(s1.x, 16); r1.y = __shfl_xor(s1.y, 16); r2.x = __shfl_xor(s2.x, 16); r2.y = __shfl_xor(s2.y, 16); r3.x = __shfl_xor(s3.x, 16); r3.y = __shfl_xor(s3.y, 16);
                    const u32x4 o1 = odd ? (u32x4){r1.x, r1.y, k1.x, k1.y} : (u32x4){k1.x, k1.y, r1.x, r1.y};
                    const u32x4 o2 = odd ? (u32x4){r2.x, r2.y, k2.x, k2.y} : (u32x4){k2.x, k2.y, r2.x, r2.y};
                    const u32x4 o3 = odd ? (u32x4){r3.x, r3.y, k3.x, k3.y} : (u32x4){k3.x, k3.y, r3.x, r3.y};
                    *(u32x4*)(PX + (size_t)row * NIN + OFF_RG + chp) = o1;
                    *(u32x4*)(PX + (size_t)row * NIN + chp) = o2;
                    *(u32x4*)((row < 32768 ? G3A + (size_t)row * WR : G3B + (size_t)(row - 32768) * WR) + chp) = o3;
                }
            }
        }
        return true;
    }
};

__device__ __forceinline__ void transpose_tile(const float* __restrict__ src, int N, bf16_t* __restrict__ dst, int ldd, int koff, int kt, int nt, float* tile) {
    const int tid = threadIdx.x, k0 = kt * 64, n0 = nt * 64;
#pragma unroll
    for (int pass = 0; pass < 2; ++pass) {
        const int r = pass * 32 + (tid >> 4), c4 = (tid & 15) * 4;
        const f32x4 v = *(const f32x4*)(src + (size_t)(k0 + r) * N + n0 + c4);
        tile[r * 65 + c4 + 0] = v.x; tile[r * 65 + c4 + 1] = v.y; tile[r * 65 + c4 + 2] = v.z; tile[r * 65 + c4 + 3] = v.w;
    }
    __syncthreads();
    {
        const int n = tid >> 3, k8 = (tid & 7) * 8;
        float v[8];
#pragma unroll
        for (int i = 0; i < 8; ++i) v[i] = tile[(k8 + i) * 65 + n];
        u32x4 w; w.x = pk_bf16(v[0], v[1]); w.y = pk_bf16(v[2], v[3]); w.z = pk_bf16(v[4], v[5]); w.w = pk_bf16(v[6], v[7]);
        *(u32x4*)(dst + (size_t)(n0 + n) * ldd + koff + k0 + k8) = w;
    }
    __syncthreads();
}

__device__ __forceinline__ void phase_prep(const Params& p_unused, unsigned char* smem) {
    const Params p = load_params();
    unsigned char* ws = p.ws;
    float* tile = (float*)smem;
    const int tid = threadIdx.x, G = gridDim.x;
    for (int task = blockIdx.x; task < 4608; task += G) {
        int t = task;
        if (t < 1664) { transpose_tile(p.in[7], NIN, (bf16_t*)(ws + WS_WIN), 1024, 0, t / 104, t % 104, tile); continue; } t -= 1664;
        if (t < 320) { transpose_tile(p.in[18], 1024, (bf16_t*)(ws + WS_WPRG), 2304, 0, t / 16, t % 16, tile); continue; } t -= 320;
        if (t < 256) { transpose_tile(p.in[19], 1024, (bf16_t*)(ws + WS_WPRG), 2304, 1280, t / 16, t % 16, tile); continue; } t -= 256;
        if (t < 256) { transpose_tile(p.in[20], 1024, (bf16_t*)(ws + WS_WOUT), 1024, 0, t / 16, t % 16, tile); continue; } t -= 256;
        if (t < 1408) { transpose_tile(p.in[22], 5632, (bf16_t*)(ws + WS_WUP), 1024, 0, t / 88, t % 88, tile); continue; } t -= 1408;
        transpose_tile(p.in[25], 1024, (bf16_t*)(ws + WS_WDN), 2816, 0, t / 16, t % 16, tile);
    }
    {
        bf16_t* WG = (bf16_t*)(ws + WS_WG);
        const float* wa = p.in[11]; const float* wx = p.in[13];
        for (int e = blockIdx.x * 512 + tid; e < 20 * 256 * 256; e += G * 512) {
            const int jj0 = e & 63, k = (e >> 6) & 255, rest = e >> 14;
            const int gate = rest & 1, dir = (rest >> 1) & 1, pn = rest >> 2;
            const int head = pn >> 2, quarter = pn & 3;
            const float v = (gate ? wx : wa)[((size_t)(dir * 5 + head) * 256 + k) * 256 + quarter * 64 + jj0];
            const int wc = jj0 >> 4, fq = (jj0 >> 2) & 3, j = jj0 & 3;
            const int c = 128 * dir + 32 * wc + 16 * gate + 4 * fq + j;
            WG[((size_t)pn * 256 + c) * 256 + k] = (bf16_t)(pk_bf16(v, v) & 0xffffu);
        }
    }
    {
        bf16_t* WS_ = (bf16_t*)(ws + WS_WS); const float* w_s = p.in[16];
        for (int e = blockIdx.x * 512 + tid; e < 8 * 128 * 128 / 2; e += G * 512) ((unsigned*)WS_)[e] = pk_bf16(w_s[2 * e], w_s[2 * e + 1]);
    }
    {
        float* SPT = (float*)(ws + WS_SPT); const float* lam = p.in[10]; const float* ba = p.in[12]; const float* bx = p.in[14];
        for (int e = blockIdx.x * 512 + tid; e < 2 * WR; e += G * 512) {
            SPT[e] = -1.4426950408889634f * ba[e]; SPT[2 * WR + e] = -1.4426950408889634f * bx[e];
            SPT[4 * WR + e] = -8.0f * 1.4426950408889634f * log1pf(expf(-lam[e]));
        }
    }
    {
        const float* c = p.in[1]; const float* cctx = p.in[3]; const float* w_mod = p.in[4];
        float* MPART = (float*)(ws + WS_MPART);
        const int lane = tid & 63, wid = tid >> 6;
        for (int task = blockIdx.x * 8 + wid; task < 1536; task += G * 8) {
            const int cgp = task % 96, ks = task / 96, col = cgp * 64 + lane;
#define REP9(X) X(0) X(1) X(2) X(3) X(4) X(5) X(6) X(7) X(8)
#define GV_DECL(v) float sv##v, a9_##v = 0.f; { const float x = ((v) < 8) ? c[(v) * 1024 + ks * 64 + lane] : cctx[ks * 64 + lane]; sv##v = x / (1.0f + __expf(-x)); }
            REP9(GV_DECL)
#pragma unroll 8
            for (int kk = 0; kk < 64; ++kk) {
                const float w = w_mod[(size_t)(ks * 64 + kk) * 6144 + col];
#define GV_FMA(v) a9_##v += __int_as_float(__builtin_amdgcn_readlane(__float_as_int(sv##v), kk)) * w;
                REP9(GV_FMA)
            }
#define GV_ST(v) MPART[((size_t)ks * 9 + (v)) * 6144 + col] = a9_##v;
            REP9(GV_ST)
#undef GV_DECL
#undef GV_FMA
#undef GV_ST
        }
    }
}

template <bool SRC_BF16> __device__ __forceinline__ void row_load16(const void* srow, int lane, f32x4 (&a)[4]) {
    if (SRC_BF16) {
        const u32x4* s = (const u32x4*)srow;
        const u32x4 v0 = s[lane], v1 = s[64 + lane];
        a[0] = (f32x4){bf_lo(v0.x), bf_hi(v0.x), bf_lo(v0.y), bf_hi(v0.y)}; a[1] = (f32x4){bf_lo(v0.z), bf_hi(v0.z), bf_lo(v0.w), bf_hi(v0.w)};
        a[2] = (f32x4){bf_lo(v1.x), bf_hi(v1.x), bf_lo(v1.y), bf_hi(v1.y)}; a[3] = (f32x4){bf_lo(v1.z), bf_hi(v1.z), bf_lo(v1.w), bf_hi(v1.w)};
    } else {
        const f32x4* s = (const f32x4*)srow;
        a[0] = s[lane * 2]; a[1] = s[lane * 2 + 1]; a[2] = s[128 + lane * 2]; a[3] = s[128 + lane * 2 + 1];
    }
}
__device__ __forceinline__ float row_rstd(const f32x4 (&a)[4]) {
    float ss = 0.f;
#pragma unroll
    for (int i = 0; i < 4; ++i) ss += a[i].x * a[i].x + a[i].y * a[i].y + a[i].z * a[i].z + a[i].w * a[i].w;
#pragma unroll
    for (int o = 32; o > 0; o >>= 1) ss += __shfl_xor(ss, o);
    return rsqrtf(ss * (1.0f / 1024.0f) + 1e-6f);
}
template <bool SRC_BF16> __device__ __forceinline__ void row_norm_mod(const void* srow, bf16_t* __restrict__ drow, const float* gs, const float* sh, int lane) {
    f32x4 a[4]; row_load16<SRC_BF16>(srow, lane, a);
    const float rstd = row_rstd(a);
#pragma unroll
    for (int hlf = 0; hlf < 2; ++hlf) {
        const int c0 = hlf * 512 + lane * 8;
        const f32x4 g0 = *(const f32x4*)(gs + c0), g1 = *(const f32x4*)(gs + c0 + 4), h0 = *(const f32x4*)(sh + c0), h1 = *(const f32x4*)(sh + c0 + 4);
        const f32x4 y0 = a[hlf * 2] * rstd * g0 + h0, y1 = a[hlf * 2 + 1] * rstd * g1 + h1;
        u32x4 w; w.x = pk_bf16(y0.x, y0.y); w.y = pk_bf16(y0.z, y0.w); w.z = pk_bf16(y1.x, y1.y); w.w = pk_bf16(y1.z, y1.w);
        *(u32x4*)(drow + c0) = w;
    }
}

template <bool FIRST> __device__ __forceinline__ void phase_norm(const Params& p_unused, unsigned char* smem) {
    const Params p = load_params();
    unsigned char* ws = p.ws;
    const int tid = threadIdx.x, lane = tid & 63, wid = tid >> 6, G = gridDim.x;
    float* gs = (float*)smem; float* sh = gs + 1024; float* gsc = sh + 1024; float* shc = gsc + 1024;
    const float* MPART = (const float*)(ws + WS_MPART); float* MFIN = (float*)(ws + WS_MFIN);
    const float* b_mod = p.in[5];
    const float* gn = FIRST ? p.in[6] : p.in[21];
    if (FIRST) {
        for (int e = blockIdx.x * 512 + tid; e < 9 * 6144; e += G * 512) {
            const int v = e / 6144, col = e % 6144; float s = b_mod[col];
#pragma unroll
            for (int ks = 0; ks < 16; ++ks) s += MPART[((size_t)ks * 9 + v) * 6144 + col];
            MFIN[e] = s;
        }
    }
    for (int grp = blockIdx.x; grp < 256; grp += G) {
        const int b = grp >> 5;
        __syncthreads();
        for (int e = tid; e < 2048; e += 512) {
            const int col = (FIRST ? 0 : 3 * 1024) + e;
            float s, sc = 0.f;
            if (FIRST) { s = b_mod[col]; sc = b_mod[col];
#pragma unroll
                for (int ks = 0; ks < 16; ++ks) { s += MPART[((size_t)ks * 9 + b) * 6144 + col]; sc += MPART[((size_t)ks * 9 + 8) * 6144 + col]; } }
            else s = MFIN[(size_t)b * 6144 + col];
            if (e < 1024) { sh[e] = s; if (FIRST) shc[e] = sc; }
            else { gs[e - 1024] = gn[e - 1024] * (1.0f + s); if (FIRST) gsc[e - 1024] = gn[e - 1024] * (1.0f + sc); }
        }
        __syncthreads();
        bf16_t* dst = FIRST ? (bf16_t*)p.out : (bf16_t*)(ws + WS_H2);
        for (int i = 0; i < 32; ++i) { const size_t row = (size_t)grp * 256 + wid * 32 + i;
            if (FIRST) row_norm_mod<false>(p.in[0] + row * DM, dst + row * DM, gs, sh, lane);
            else row_norm_mod<true>((const bf16_t*)p.out + row * DM, dst + row * DM, gs, sh, lane); }
        if (FIRST) { const size_t crow = (size_t)grp * 8 + wid; row_norm_mod<false>(p.in[2] + crow * DM, (bf16_t*)p.out + ((size_t)MROWS + crow) * DM, gsc, shc, lane); }
    }
}

__device__ __forceinline__ void phase_conv1d(const Params& p_unused) {
    const Params p = load_params();
    unsigned char* ws = p.ws;
    const bf16_t* PX = (const bf16_t*)(ws + WS_PX); const bf16_t* PC = (const bf16_t*)(ws + WS_PC);
    bf16_t* XR = (bf16_t*)p.out;
    const float* cw = p.in[8]; const float* cb = p.in[9];
    const int lane = threadIdx.x & 63, gw = blockIdx.x * 8 + (threadIdx.x >> 6), nw = gridDim.x * 8;
    const int nslot = nw / 5;
    if (gw >= nslot * 5) return;
    const int gb = gw % 5, slot = gw / 5, ch = gb * 256 + lane * 4;
    const int total = MROWS + MCTX, per = (total + nslot - 1) / nslot;
    const int r0 = slot * per, r1 = (r0 + per < total) ? r0 + per : total;
    const f32x4 w0 = *(const f32x4*)(cw + 0 * WR + ch), w1 = *(const f32x4*)(cw + 1 * WR + ch), w2 = *(const f32x4*)(cw + 2 * WR + ch), w3 = *(const f32x4*)(cw + 3 * WR + ch);
    const f32x4 bias = *(const f32x4*)(cb + ch);
#pragma unroll 4
    for (int row = r0; row < r1; ++row) {
        const bf16_t* src; int ld, t, T;
        if (row < MROWS) { t = row & (SEQ - 1); T = SEQ; src = PX + (size_t)row * NIN + ch; ld = NIN; }
        else { const int r2 = row - MROWS; t = r2 & (CTXL - 1); T = CTXL; src = PC + (size_t)r2 * WR + ch; ld = WR; }
        const u32x2 z = {0u, 0u};
        const u32x2 v0 = (t >= 2) ? *(const u32x2*)(src - 2 * (long)ld) : z;
        const u32x2 v1 = (t >= 1) ? *(const u32x2*)(src - (long)ld) : z;
        const u32x2 v2 = *(const u32x2*)(src);
        const u32x2 v3 = (t + 1 < T) ? *(const u32x2*)(src + ld) : z;
        f32x4 a = bias;
        a += w0 * (f32x4){bf_lo(v0.x), bf_hi(v0.x), bf_lo(v0.y), bf_hi(v0.y)};
        a += w1 * (f32x4){bf_lo(v1.x), bf_hi(v1.x), bf_lo(v1.y), bf_hi(v1.y)};
        a += w2 * (f32x4){bf_lo(v2.x), bf_hi(v2.x), bf_lo(v2.y), bf_hi(v2.y)};
        a += w3 * (f32x4){bf_lo(v3.x), bf_hi(v3.x), bf_lo(v3.y), bf_hi(v3.y)};
        u32x2 w; w.x = pk_bf16(a.x, a.y); w.y = pk_bf16(a.z, a.w);
        *(u32x2*)(XR + (size_t)row * WR + ch) = w;
    }
}

__device__ __forceinline__ void phase_chunk_mlp(const Params& p_unused, unsigned char* smem) {
    const Params p = load_params();
    unsigned char* ws = p.ws;
    bf16_t* PX = (bf16_t*)(ws + WS_PX);
    const bf16_t* WSb = (const bf16_t*)(ws + WS_WS); const float* VSS = (const float*)(ws + WS_VSS);
    const float* g_v = p.in[15]; const float* b_s = p.in[17];
    constexpr int LDT = 136;
    bf16_t* Wl = (bf16_t*)smem; bf16_t* Vt = Wl + 128 * LDT; float* rs = (float*)(Vt + 128 * LDT);
    const int tid = threadIdx.x, lane = tid & 63, wid = tid >> 6, fr = lane & 15, fq = lane >> 4;
    int cur_h = -1;
    const int p0 = (wid >> 1) * 32, c0 = (wid & 1) * 64;
    for (int task = blockIdx.x; task < NB * 64 * 8; task += gridDim.x) {
        const int h = task & 7, n = (task >> 3) & 63, b = task >> 9;
        const size_t row0 = (size_t)b * SEQ + (size_t)n * 128;
        __syncthreads();
        if (tid < 128) { const f32x4* q = (const f32x4*)(VSS + (row0 + tid) * 16); const f32x4 s = q[0] + q[1] + q[2] + q[3]; rs[tid] = rsqrtf((s.x + s.y + s.z + s.w) * (1.0f / 1024.0f) + 1e-6f); }
        if (h != cur_h) {
            cur_h = h;
#pragma unroll
            for (int i = 0; i < 4; ++i) { const int e = tid + i * 512, r = e >> 4, c8 = (e & 15) * 8;
                *(u32x4*)(Wl + r * LDT + c8) = *(const u32x4*)(WSb + (size_t)h * 16384 + r * 128 + c8); }
        }
        u32x4 vraw[4];
#pragma unroll
        for (int i = 0; i < 4; ++i) { const int e = tid + i * 512, q = e >> 4, c8 = (e & 15) * 8; vraw[i] = *(const u32x4*)(PX + (row0 + q) * NIN + OFF_V + h * 128 + c8); }
        u32x2 uraw[2][4];
#pragma unroll
        for (int mi = 0; mi < 2; ++mi)
#pragma unroll
            for (int ni = 0; ni < 4; ++ni) uraw[mi][ni] = *(const u32x2*)(PX + (row0 + p0 + mi * 16 + fr) * NIN + OFF_U + h * 128 + c0 + ni * 16 + fq * 4);
        __syncthreads();
#pragma unroll
        for (int i = 0; i < 4; ++i) { const int e = tid + i * 512, q = e >> 4, c8 = (e & 15) * 8;
            const u32x4 v = vraw[i];
            const float r = rs[q];
            const f32x4 g0 = *(const f32x4*)(g_v + h * 128 + c8), g1 = *(const f32x4*)(g_v + h * 128 + c8 + 4);
            const float f[8] = {bf_lo(v.x) * r * g0.x, bf_hi(v.x) * r * g0.y, bf_lo(v.y) * r * g0.z, bf_hi(v.y) * r * g0.w,
                                bf_lo(v.z) * r * g1.x, bf_hi(v.z) * r * g1.y, bf_lo(v.w) * r * g1.z, bf_hi(v.w) * r * g1.w};
            const int qp = ((((q >> 3) ^ (c8 >> 3)) & 15) << 3) | (q & 7);
#pragma unroll
            for (int k = 0; k < 8; k += 2) { const unsigned w = pk_bf16(f[k], f[k + 1]); Vt[(c8 + k) * LDT + qp] = (bf16_t)(w & 0xffffu); Vt[(c8 + k + 1) * LDT + qp] = (bf16_t)(w >> 16); }
        }
        __syncthreads();
        f32x4 acc[2][4];
#pragma unroll
        for (int mi = 0; mi < 2; ++mi)
#pragma unroll
            for (int ni = 0; ni < 4; ++ni) acc[mi][ni] = (f32x4){0.f, 0.f, 0.f, 0.f};
#pragma unroll
        for (int kk = 0; kk < 4; ++kk) {
            bf16x8 af[2], bfv[4];
#pragma unroll
            for (int mi = 0; mi < 2; ++mi) af[mi] = *(const bf16x8*)(Wl + (p0 + mi * 16 + fr) * LDT + kk * 32 + fq * 8);
#pragma unroll
            for (int ni = 0; ni < 4; ++ni) { const int cr = c0 + ni * 16 + fr; bfv[ni] = *(const bf16x8*)(Vt + cr * LDT + ((((kk * 4 + fq) ^ (cr >> 3)) & 15) << 3)); }
#pragma unroll
            for (int mi = 0; mi < 2; ++mi)
#pragma unroll
                for (int ni = 0; ni < 4; ++ni) acc[mi][ni] = __builtin_amdgcn_mfma_f32_16x16x32_bf16(bfv[ni], af[mi], acc[mi][ni], 0, 0, 0);
        }
#pragma unroll
        for (int mi = 0; mi < 2; ++mi) {
            const int pp = p0 + mi * 16 + fr; const float bias = b_s[pp * 8 + h];
#pragma unroll
            for (int ni = 0; ni < 4; ++ni) {
                bf16_t* up = PX + (row0 + pp) * NIN + OFF_U + h * 128 + c0 + ni * 16 + fq * 4;
                const u32x2 uv = uraw[mi][ni];
                const f32x2 u01 = gelu_pk2((f32x2){bf_lo(uv.x), bf_hi(uv.x)}), u23 = gelu_pk2((f32x2){bf_lo(uv.y), bf_hi(uv.y)});
                u32x2 w; w.x = pk_bf16(u01.x * (acc[mi][ni].x + bias), u01.y * (acc[mi][ni].y + bias));
                w.y = pk_bf16(u23.x * (acc[mi][ni].z + bias), u23.y * (acc[mi][ni].w + bias));
                *(u32x2*)up = w;
            }
        }
    }
}

__device__ __forceinline__ void phase_carry_fix(const Params& p_unused, unsigned char* smem) {
    const Params p = load_params();
    unsigned char* ws = p.ws;
    const float2* __restrict__ AGG = (const float2*)(ws + WS_AGG);
    bf16_t* PX = (bf16_t*)(ws + WS_PX);
    const bf16_t* G3A = (const bf16_t*)(ws + WS_G3A); const bf16_t* G3B = (const bf16_t*)((const unsigned char*)p.out + OUT_G3B);
    float* carr = (float*)smem;
    const int tid = threadIdx.x;
    for (int grp = blockIdx.x; grp < 256; grp += gridDim.x) {
        const int b = grp >> 5, q = grp & 31, c0 = 4 + 4 * q;
        __syncthreads();
#pragma unroll 1
        for (int k = 0; k < 5; ++k) {
            const int sidx = tid + k * 512, dir = sidx / WR, ch = sidx - dir * WR;
            const float2* ag = AGG + (size_t)(b * 2 + dir) * NCH * WR + ch;
            float* cr = carr + (size_t)dir * 4 * WR + ch;
            float h = 0.f;
            if (dir == 0) {
#pragma unroll 8
                for (int ci = 0; ci < c0; ++ci) { const float2 ab = ag[(size_t)ci * WR]; h = ab.x * h + ab.y; }
#pragma unroll
                for (int e = 0; e < 4; ++e) { const float2 ab = ag[(size_t)(c0 + e) * WR]; cr[e * WR] = h; h = ab.x * h + ab.y; }
            } else {
#pragma unroll
                for (int ci = 3; ci >= 0; --ci) { const float2 ab = ag[(size_t)ci * WR]; h = ab.x * h + ab.y; }
#pragma unroll 8
                for (int ci = NCH - 1; ci > c0 + 3; --ci) { const float2 ab = ag[(size_t)ci * WR]; h = ab.x * h + ab.y; }
#pragma unroll
                for (int e = 3; e >= 0; --e) { const float2 ab = ag[(size_t)(c0 + e) * WR]; cr[e * WR] = h; h = ab.x * h + ab.y; }
            }
        }
        __syncthreads();
        const size_t row0 = (size_t)grp * 256;
#pragma unroll 2
        for (int it = tid; it < 256 * 160; it += 512) {
            const int r = it / 160, ch = (it - r * 160) * 8, e = r >> 6;
            const size_t row = row0 + r;
            bf16_t* p1 = PX + row * NIN + OFF_RG + ch;
            const u32x4 g1 = *(const u32x4*)p1;
            const u32x4 g2 = *(const u32x4*)(PX + row * NIN + ch);
            const u32x4 g3 = *(const u32x4*)((row < 32768 ? G3A + row * WR : G3B + (row - 32768) * WR) + ch);
            const f32x4 cf0 = *(const f32x4*)(carr + e * WR + ch), cf1 = *(const f32x4*)(carr + e * WR + ch + 4);
            const f32x4 cb0 = *(const f32x4*)(carr + (4 + e) * WR + ch), cb1 = *(const f32x4*)(carr + (4 + e) * WR + ch + 4);
            u32x4 w;
            w.x = pk_bf16(bf_lo(g1.x) + bf_lo(g2.x) * cf0.x + bf_lo(g3.x) * cb0.x, bf_hi(g1.x) + bf_hi(g2.x) * cf0.y + bf_hi(g3.x) * cb0.y);
            w.y = pk_bf16(bf_lo(g1.y) + bf_lo(g2.y) * cf0.z + bf_lo(g3.y) * cb0.z, bf_hi(g1.y) + bf_hi(g2.y) * cf0.w + bf_hi(g3.y) * cb0.w);
            w.z = pk_bf16(bf_lo(g1.z) + bf_lo(g2.z) * cf1.x + bf_lo(g3.z) * cb1.x, bf_hi(g1.z) + bf_hi(g2.z) * cf1.y + bf_hi(g3.z) * cb1.y);
            w.w = pk_bf16(bf_lo(g1.w) + bf_lo(g2.w) * cf1.z + bf_lo(g3.w) * cb1.z, bf_hi(g1.w) + bf_hi(g2.w) * cf1.w + bf_hi(g3.w) * cb1.w);
            *(u32x4*)p1 = w;
        }
    }
}

__device__ __forceinline__ void c2_load(u32x2 (&raw)[6], const bf16_t* base, int gi0, int jj) {
#pragma unroll
    for (int r = 0; r < 6; ++r) {
        const int ii = gi0 - 1 + r;
        const bool ok = (ii >= 0) && (ii < 128) && (jj >= 0) && (jj < 64);
        const u32x2 z = {0u, 0u};
        raw[r] = ok ? *(const u32x2*)(base + (size_t)(ii * 64 + jj) * DFF) : z;
    }
}
__device__ __forceinline__ void c2_unpack(f32x4 (&W)[6], const u32x2 (&raw)[6]) {
#pragma unroll
    for (int r = 0; r < 6; ++r) W[r] = (f32x4){bf_lo(raw[r].x), bf_hi(raw[r].x), bf_lo(raw[r].y), bf_hi(raw[r].y)};
}
__device__ __forceinline__ void c2_step(const f32x4 (&A)[6], const f32x4 (&B)[6], f32x4 (&C)[6], u32x2 (&raw)[6], const f32x4 (&w)[9], const f32x4 bias,
                                        const bf16_t* ugb, bf16_t* uvb, int gi0, int j) {
    c2_unpack(C, raw);
    c2_load(raw, ugb, gi0, j + 2);
#pragma unroll
    for (int r = 0; r < 4; ++r) {
        f32x4 a = bias;
#pragma unroll
        for (int di = 0; di < 3; ++di) a += w[di * 3 + 0] * A[r + di] + w[di * 3 + 1] * B[r + di] + w[di * 3 + 2] * C[r + di];
        bf16_t* up = uvb + (size_t)((gi0 + r) * 64 + j) * DFF;
        const u32x2 uv = *(const u32x2*)up;
        const f32x2 g0 = gelu_pk2((f32x2){a.x, a.y}), g1 = gelu_pk2((f32x2){a.z, a.w});
        u32x2 o; o.x = pk_bf16(g0.x * bf_lo(uv.x), g0.y * bf_hi(uv.x)); o.y = pk_bf16(g1.x * bf_lo(uv.y), g1.y * bf_hi(uv.y));
        *(u32x2*)up = o;
    }
}
__device__ __forceinline__ void phase_conv2d(const Params& p_unused) {
    const Params p = load_params();
    unsigned char* ws = p.ws;
    const bf16_t* UG = (const bf16_t*)(ws + WS_UG); bf16_t* UV = (bf16_t*)(ws + WS_UV);
    const float* cw = p.in[23]; const float* cb = p.in[24];
    const int lane = threadIdx.x & 63, gw = blockIdx.x * 8 + (threadIdx.x >> 6), nw = gridDim.x * 8;
    for (int task = gw; task < 11 * 8 * 32 * 2; task += nw) {
        const int gb = task % 11, rest = task / 11, half = rest & 1, band = (rest >> 1) & 31, b = rest >> 6;
        const int ch = gb * 256 + lane * 4, gi0 = band * 4, j0 = half * 32;
        f32x4 w[9];
#pragma unroll
        for (int k = 0; k < 9; ++k) w[k] = *(const f32x4*)(cw + k * DFF + ch);
        const f32x4 bias = *(const f32x4*)(cb + ch);
        const bf16_t* ugb = UG + (size_t)b * SEQ * DFF + ch; bf16_t* uvb = UV + (size_t)b * SEQ * DFF + ch;
        f32x4 W0[6], W1[6], W2[6]; u32x2 raw[6];
        c2_load(raw, ugb, gi0, j0 - 1); c2_unpack(W0, raw);
        c2_load(raw, ugb, gi0, j0); c2_unpack(W1, raw);
        c2_load(raw, ugb, gi0, j0 + 1);
        const int jend = j0 + 32;
#pragma unroll 1
        for (int j = j0; j < jend; j += 3) {
            c2_step(W0, W1, W2, raw, w, bias, ugb, uvb, gi0, j);
            if (j + 1 < jend) c2_step(W1, W2, W0, raw, w, bias, ugb, uvb, gi0, j + 1);
            if (j + 2 < jend) c2_step(W2, W0, W1, raw, w, bias, ugb, uvb, gi0, j + 2);
        }
    }
}

__device__ __forceinline__ void phase_final(const Params& p_unused) {
    const Params p = load_params();
    const float* gf = p.in[26];
    const bf16_t* X2 = (const bf16_t*)(p.ws + WS_H2);
    const int lane = threadIdx.x & 63, wid = threadIdx.x >> 6;
    f32x4 g[4] = {*(const f32x4*)(gf + lane * 8), *(const f32x4*)(gf + lane * 8 + 4), *(const f32x4*)(gf + 512 + lane * 8), *(const f32x4*)(gf + 512 + lane * 8 + 4)};
    for (int row = blockIdx.x * 8 + wid; row < MROWS; row += gridDim.x * 8) {
        f32x4 a[4]; row_load16<true>(X2 + (size_t)row * DM, lane, a);
        const float rstd = row_rstd(a);
        f32x4* d = (f32x4*)(p.out + (size_t)row * DM);
        __builtin_nontemporal_store(a[0] * rstd * g[0], d + lane * 2); __builtin_nontemporal_store(a[1] * rstd * g[1], d + lane * 2 + 1);
        __builtin_nontemporal_store(a[2] * rstd * g[2], d + 128 + lane * 2); __builtin_nontemporal_store(a[3] * rstd * g[3], d + 128 + lane * 2 + 1);
    }
}

#define XB_TMO      128
#define XB_XCNT(j)  (256  + 64 * (j))
#define XB_XSUB(j)  (1280 + 64 * (j))
#define XB_XGEN(j)  (2304 + 64 * (j))
#define XB_TOP      3328
#define XB_TOPGEN   3392
#define XCD_BAR_WORDS 3456
#define XB_SPIN_CAP (1u << 18)
__device__ __forceinline__ unsigned xb_ld(unsigned* p)              { return __hip_atomic_load(p, __ATOMIC_RELAXED, __HIP_MEMORY_SCOPE_AGENT); }
__device__ __forceinline__ unsigned xb_add(unsigned* p, unsigned v) { return __hip_atomic_fetch_add(p, v, __ATOMIC_RELAXED, __HIP_MEMORY_SCOPE_AGENT); }
__device__ __forceinline__ unsigned xb_xcc_id() { return (unsigned)__builtin_amdgcn_s_getreg((3 << 11) | 20) & 0xFu; }
#define XB_SPIN(cond, bar) do { unsigned _sp = 0; while (cond) { __builtin_amdgcn_s_sleep(1); \
    if ((++_sp & 255u) == 0u) { if (xb_ld(&(bar)[XB_TMO])) break; if (_sp > XB_SPIN_CAP) { atomicAdd(&(bar)[XB_TMO], 1u); break; } } } } while (0)
struct XcdBarrier { unsigned* bar; unsigned x; volatile LAS unsigned* st; };
__device__ __forceinline__ XcdBarrier xcd_barrier_post(unsigned* bar, volatile LAS unsigned* st) {
    XcdBarrier b; b.bar = bar; b.x = xb_xcc_id(); b.st = st;
    if (threadIdx.x == 0) (void)xb_add(&bar[XB_XCNT(b.x)], 1u);
    return b;
}
__device__ __forceinline__ void xcd_barrier_complete(unsigned* bar, unsigned x, unsigned& nloc, unsigned& nx) {
    const unsigned G = gridDim.x * gridDim.y * gridDim.z;
    unsigned sum, cnt, mine, sp = 0u;
    for (;;) {
        sum = 0u; cnt = 0u; mine = 0u;
#pragma unroll
        for (unsigned j = 0; j < 16; ++j) { const unsigned c = xb_ld(&bar[XB_XCNT(j)]); sum += c; cnt += (c > 0u) ? 1u : 0u; mine = (j == x) ? c : mine; }
        if (sum == G) break;
        __builtin_amdgcn_s_sleep(1);
        if ((++sp & 255u) == 0u) { if (xb_ld(&bar[XB_TMO])) break; if (sp > XB_SPIN_CAP) { atomicAdd(&bar[XB_TMO], 1u); break; } }
    }
    nloc = mine > 0u ? mine : 1u; nx = cnt > 0u ? cnt : 1u;
}
__device__ __forceinline__ void xcd_barrier(const XcdBarrier& b) {
    asm volatile("s_waitcnt vmcnt(0)" ::: "memory");
    __syncthreads();
    if (threadIdx.x == 0) {
        unsigned* bar = b.bar;
        __builtin_amdgcn_s_waitcnt(0);
        unsigned nloc = b.st[0], nx = b.st[1];
        if (nloc == 0u) { xcd_barrier_complete(bar, b.x, nloc, nx); b.st[0] = nloc; b.st[1] = nx; }
        const unsigned old = xb_add(&bar[XB_XSUB(b.x)], 1u);
        const unsigned gen = old / nloc;
        if (old + 1u == (gen + 1u) * nloc) {
            __builtin_amdgcn_fence(__ATOMIC_RELEASE, "agent");
            asm volatile("s_waitcnt vmcnt(0)" ::: "memory");
            const unsigned og = xb_add(&bar[XB_TOP], 1u);
            const unsigned tg = og / nx;
            if (og + 1u == (tg + 1u) * nx) xb_add(&bar[XB_TOPGEN], 1u);
            else XB_SPIN(xb_ld(&bar[XB_TOPGEN]) == tg, bar);
            __builtin_amdgcn_fence(__ATOMIC_ACQUIRE, "agent");
            xb_add(&bar[XB_XGEN(b.x)], 1u);
            asm volatile("s_waitcnt vmcnt(0)" ::: "memory");
        } else {
            XB_SPIN(xb_ld(&bar[XB_XGEN(b.x)]) == gen, bar);
            __builtin_amdgcn_fence(__ATOMIC_ACQUIRE, "agent");
            asm volatile("s_waitcnt vmcnt(0)" ::: "memory");
        }
    }
    __syncthreads();
}

__global__ void __launch_bounds__(512, 2) mega(Params p) {
    extern __shared__ __attribute__((aligned(16))) unsigned char smem[];
    LAS unsigned char* lds = (LAS unsigned char*)smem;
    const int G = gridDim.x, c = blockIdx.x;
#ifndef PH_MASK
#define PH_MASK 0x3fff
#endif
#define IN(k) (((PH_MASK >> (k)) & 1) && p.ph_lo <= (k) && (k) < p.ph_hi)
#ifndef REP_MASK
#define REP_MASK 0
#endif
#define REPS(k) _Pragma("unroll 1") for (int rep_ = 0; rep_ < (((REP_MASK >> (k)) & 1) ? 2 : 1); ++rep_)
#define SEAM(k) do { if (IN(k) && IN((k) + 1)) { if ((k) == 0) cg::this_grid().sync(); else xcd_barrier(xb); } } while (0)
    volatile LAS unsigned* xst = (volatile LAS unsigned*)(lds + 131072);
    if (threadIdx.x < 4) xst[threadIdx.x] = 0u;
    __syncthreads();
    const XcdBarrier xb = xcd_barrier_post((unsigned*)(load_params().ws + WS_BAR), xst);

    if (IN(0)) REPS(0) phase_prep(p, smem);
    SEAM(0);
    if (IN(1)) REPS(1) phase_norm<true>(p, smem);
    SEAM(1);
    if (IN(2)) REPS(2) {
        __syncthreads();
        const Params q = load_params(); unsigned char* ws = q.ws; bf16_t* PX = (bf16_t*)(ws + WS_PX); float* MFIN = (float*)(ws + WS_MFIN); (void)PX; (void)MFIN;
        pg8::GemmD g{(const bf16_t*)q.out, (const bf16_t*)(ws + WS_WIN), DM, DM};
        SchedIn S{G, c}; EpiIn E{PX, (bf16_t*)(ws + WS_PC), (float*)(ws + WS_VSS)};
        pg8::gemm_phase(lds, g, S, E);
    }
    SEAM(2);
    if (IN(3)) {
        const bool conv_first = (blockIdx.x & 1) == 0;
#pragma unroll 1
        for (int st = 0; st < 2; ++st) {
            if ((st == 0) == conv_first) phase_conv1d(p); else phase_chunk_mlp(p, smem);
        }
    }
    SEAM(3);
    if (IN(4)) REPS(4) {
        __syncthreads();
        const Params q = load_params(); unsigned char* ws = q.ws; bf16_t* PX = (bf16_t*)(ws + WS_PX);
        pg8::GemmD g{(const bf16_t*)q.out, (const bf16_t*)(ws + WS_WG), WR, 256};
        SchedGate S{264, 264 * 20, G, c};
        EpiGate E{(const bf16_t*)q.out, (const float*)(ws + WS_SPT), (const float*)(ws + WS_SPT) + 2 * WR, (const float*)(ws + WS_SPT) + 4 * WR, (float2*)(ws + WS_AGG), PX,
                  (bf16_t*)(ws + WS_G3A), (bf16_t*)((unsigned char*)q.out + OUT_G3B)};
        pg8::gemm_phase(lds, g, S, E);
    }
    SEAM(4);
    if (IN(5)) REPS(5) phase_carry_fix(p, smem);
    SEAM(5);
    if (IN(7)) REPS(7) {
        __syncthreads();
        const Params q = load_params(); unsigned char* ws = q.ws; bf16_t* PX = (bf16_t*)(ws + WS_PX); float* MFIN = (float*)(ws + WS_MFIN); (void)PX; (void)MFIN;
        pg8::GemmD g{PX + OFF_RG, (const bf16_t*)(ws + WS_WPRG), NIN, 2304};
        SchedMerge S{G, c}; EpiMerge E{PX};
        pg8::gemm_phase(lds, g, S, E);
    }
    SEAM(7);
    if (IN(8)) REPS(8) {
        __syncthreads();
        const Params q = load_params(); unsigned char* ws = q.ws; bf16_t* PX = (bf16_t*)(ws + WS_PX); float* MFIN = (float*)(ws + WS_MFIN); (void)PX; (void)MFIN;
        pg8::GemmD g{PX, (const bf16_t*)(ws + WS_WOUT), NIN, DM};
        SchedPlain S{256, 4, 1024, G, c, 16}; EpiRes<false> E{q.in[0], (bf16_t*)q.out, MFIN + 2 * 1024};
        pg8::gemm_phase(lds, g, S, E);
    }
    SEAM(8);
    if (IN(9)) REPS(9) phase_norm<false>(p, smem);
    SEAM(9);
    if (IN(10)) REPS(10) {
        __syncthreads();
        const Params q = load_params(); unsigned char* ws = q.ws; bf16_t* PX = (bf16_t*)(ws + WS_PX); float* MFIN = (float*)(ws + WS_MFIN); (void)PX; (void)MFIN;
        pg8::GemmD g{(const bf16_t*)(ws + WS_H2), (const bf16_t*)(ws + WS_WUP), DM, DM};
        SchedPlain S{256, 22, 5632, G, c, 16}; EpiUp E{(bf16_t*)(ws + WS_UG), (bf16_t*)(ws + WS_UV)};
        pg8::gemm_phase(lds, g, S, E);
    }
    SEAM(10);
    if (IN(11)) REPS(11) phase_conv2d(p);
    SEAM(11);
    if (IN(12)) REPS(12) {
        __syncthreads();
        const Params q = load_params(); unsigned char* ws = q.ws; bf16_t* PX = (bf16_t*)(ws + WS_PX); float* MFIN = (float*)(ws + WS_MFIN); (void)PX; (void)MFIN;
        pg8::GemmD g{(const bf16_t*)(ws + WS_UV), (const bf16_t*)(ws + WS_WDN), DFF, DFF};
        SchedPlain S{256, 4, 1024, G, c, 44}; EpiRes<true> E{q.out, (bf16_t*)(ws + WS_H2), MFIN + 5 * 1024};
        pg8::gemm_phase(lds, g, S, E);
    }
    SEAM(12);
    if (IN(13)) REPS(13) phase_final(p);
}

extern "C" void kernel_launch(void* const* d_in, const int* in_sizes, int n_in, void* d_out, int out_size, void* d_ws, size_t ws_size, hipStream_t stream) {
    static int grid = 0;
    if (grid == 0) {
        if (n_in != 27 || ws_size < WS_NEED) { fprintf(stderr, "kernel_launch: unexpected n_in %d / ws %zu (need %zu)\n", n_in, ws_size, (size_t)WS_NEED); grid = -1; return; }
        int dev = 0, cus = 0, per_cu = 0;
        hipGetDevice(&dev); hipDeviceGetAttribute(&cus, hipDeviceAttributeMultiprocessorCount, dev);
        if (hipFuncSetAttribute((const void*)mega, hipFuncAttributeMaxDynamicSharedMemorySize, LDS_BYTES) != hipSuccess) { fprintf(stderr, "kernel_launch: hipFuncSetAttribute failed\n"); grid = -1; return; }
        hipOccupancyMaxActiveBlocksPerMultiprocessor(&per_cu, (const void*)mega, 512, LDS_BYTES);
        (void)hipGetLastError();
        if (per_cu < 1) fprintf(stderr, "kernel_launch: occupancy query says %d blocks/CU\n", per_cu);
        grid = cus > 0 ? cus : 256;
    }
    if (grid < 0) return;
    Params p{};
    for (int i = 0; i < 27; ++i) p.in[i] = (const float*)d_in[i];
    p.out = (float*)d_out; p.ws = (unsigned char*)d_ws;
    (void)hipMemsetAsync((unsigned char*)d_ws + WS_BAR, 0, (size_t)3456 * 4, stream);
#if ONE_LAUNCH
    p.ph_lo = 0; p.ph_hi = NPH;
    void* args[] = {&p};
    hipError_t e = hipLaunchCooperativeKernel((const void*)mega, dim3(grid), dim3(512), args, LDS_BYTES, stream);
    if (e != hipSuccess) fprintf(stderr, "cooperative launch failed: %s (grid %d)\n", hipGetErrorString(e), grid);
#else
    for (int ph = 0; ph < NPH; ++ph) { p.ph_lo = ph; p.ph_hi = ph + 1; hipLaunchKernelGGL(mega, dim3(grid), dim3(512), LDS_BYTES, stream, p); }
#endif
}
```
